# Optimizing an MI355X kernel written in HIP

```python
import math
import jax
import jax.numpy as jnp
from jax import lax
import numpy as np

D_MODEL = 2048
BATCH = 1
SEQ = 8192
DEPTH = 2

CTX_LEN = 256
GRID_W = 64
N_MIXERS = 2
N_RWKV = (DEPTH + N_MIXERS - 1) // N_MIXERS
N_HYENA = DEPTH // N_MIXERS
RWKV_HEAD = 64
RWKV_HEADS = D_MODEL // RWKV_HEAD
DECAY_LORA = 96
ICLR_LORA = 96
GATE_LORA = 256
GN_EPS = 64e-5
L2_EPS = 1e-12
HYENA_EMB = 33
HYENA_WIDTH = 64
HYENA_TARGET = 1e-2
HYENA_PCT_SHORT = 0.3
HYENA_PCT_LONG = 1.5
HYENA_MAX_DECAY = math.log(HYENA_TARGET) / HYENA_PCT_SHORT
HYENA_MIN_DECAY = math.log(HYENA_TARGET) / HYENA_PCT_LONG
FFN_HIDDEN = int(math.ceil(8 * D_MODEL / 3 / 256)) * 256
RMS_EPS = 1e-6
F32 = jnp.float32

kernel_name = "hybrid_rwkv7_hyena_dit_prefix"


def rms_norm(x, g):
    x32 = x.astype(F32)
    y = x32 * lax.rsqrt(jnp.mean(x32 * x32, axis=-1, keepdims=True) + RMS_EPS)
    return y.astype(x.dtype) * g


def modulate(h, shift, scale):
    return h * (1 + scale) + shift


def swiglu(h, w1, w3, w2):
    return (jax.nn.silu(h @ w1) * (h @ w3)) @ w2


def seq_shift(h):
    half = h.shape[-1] // 2
    prev = jnp.pad(h[:, :-1, :half], ((0, 0), (1, 0), (0, 0)))
    nxt = jnp.pad(h[:, 1:, half:], ((0, 0), (0, 1), (0, 0)))
    return jnp.concatenate([prev, nxt], axis=-1)


def grid_shift(h):
    B, L, D = h.shape
    rows = L // GRID_W
    g = h.reshape(B, rows, GRID_W, D)
    q = D // 4
    left = jnp.pad(g[:, :, :-1, :q], ((0, 0), (0, 0), (1, 0), (0, 0)))
    right = jnp.pad(g[:, :, 1:, q:2 * q], ((0, 0), (0, 0), (0, 1), (0, 0)))
    up = jnp.pad(g[:, :-1, :, 2 * q:3 * q], ((0, 0), (1, 0), (0, 0), (0, 0)))
    down = jnp.pad(g[:, 1:, :, 3 * q:], ((0, 0), (0, 1), (0, 0), (0, 0)))
    return jnp.concatenate([left, right, up, down], axis=-1).reshape(B, L, D)


def rwkv7_inputs(h, hs, p):
    B, L, D = h.shape
    H, N = RWKV_HEADS, RWKV_HEAD
    xx = hs - h
    xr, xw, xk, xv, xa, xg = [h + xx * p["mu"][m] for m in range(6)]
    r = (xr @ p["w_r"]).reshape(B, L, H, N).astype(F32)
    k = (xk @ p["w_k"]).reshape(B, L, H, N).astype(F32)
    v = (xv @ p["w_v"]).reshape(B, L, H, N).astype(F32)
    kk = k * p["k_k"].reshape(H, N)
    kk = kk / jnp.maximum(jnp.linalg.norm(kk, axis=-1, keepdims=True), L2_EPS)
    dirs = []
    for d in range(2):
        w_log = -jax.nn.softplus(-(p["w0"][d] + jnp.tanh(xw @ p["w1"][d]) @ p["w2"][d]).astype(F32)) - 0.5
        decay = jnp.exp(-jnp.exp(w_log)).reshape(B, L, H, N)
        a = jax.nn.sigmoid((p["a0"][d] + (xa @ p["a1"][d]) @ p["a2"][d]).astype(F32)).reshape(B, L, H, N)
        k_d = k * (1 + (a - 1) * p["k_a"].reshape(H, N))
        dirs.append((decay, k_d, kk * a))
    return {"r": r, "v": v, "kk": kk, "xg": xg, "dirs": dirs}


def wkv7_scan(r, decay, k, v, kk, b, s0, reverse):
    def step(s, inp):
        r_t, w_t, k_t, v_t, kk_t, b_t = inp
        sa = jnp.einsum("bhvk,bhk->bhv", s, -kk_t)
        s = s * w_t[:, :, None, :] + sa[..., None] * b_t[:, :, None, :] + v_t[..., None] * k_t[:, :, None, :]
        return s, jnp.einsum("bhvk,bhk->bhv", s, r_t)
    xs = tuple(jnp.moveaxis(t, 1, 0) for t in (r, decay, k, v, kk, b))
    s_fin, ys = lax.scan(step, s0, xs, reverse=reverse)
    return jnp.moveaxis(ys, 0, 1), s_fin


def rwkv7_readout(y, q, p, dtype):
    B, L, H, N = y.shape
    mean = jnp.mean(y, axis=-1, keepdims=True)
    var = jnp.mean(jnp.square(y - mean), axis=-1, keepdims=True)
    yn = ((y - mean) * lax.rsqrt(var + GN_EPS)).reshape(B, L, H * N) * p["lnx_w"] + p["lnx_b"]
    k_both = q["dirs"][0][1] + q["dirs"][1][1]
    bonus = jnp.sum(q["r"] * k_both * p["r_k"], axis=-1, keepdims=True) * q["v"]
    g = jax.nn.sigmoid(q["xg"] @ p["g1"]) @ p["g2"]
    return ((yn + bonus.reshape(B, L, H * N)) * g).astype(dtype) @ p["w_o"]


def rwkv7_mixer(hc, hl, p, ctx_out):
    B = hl.shape[0]
    qc = rwkv7_inputs(hc, seq_shift(hc), p)
    ql = rwkv7_inputs(hl, grid_shift(hl), p)
    s_zero = jnp.zeros((B, RWKV_HEADS, RWKV_HEAD, RWKV_HEAD), F32)
    yc_sum = 0.0
    yl_sum = 0.0
    for d, reverse in enumerate((False, True)):
        decay_c, k_c, b_c = qc["dirs"][d]
        yc, s_c = wkv7_scan(qc["r"], decay_c, k_c, qc["v"], qc["kk"], b_c, s_zero, reverse)
        decay_l, k_l, b_l = ql["dirs"][d]
        yl, _ = wkv7_scan(ql["r"], decay_l, k_l, ql["v"], ql["kk"], b_l, s_c, reverse)
        yc_sum = yc_sum + yc
        yl_sum = yl_sum + yl
    out_l = rwkv7_readout(yl_sum, ql, p, hl.dtype)
    out_c = rwkv7_readout(yc_sum, qc, p, hc.dtype) if ctx_out else None
    return out_l, out_c


def centred_conv3(u, w, b):
    up = jnp.pad(u, ((0, 0), (1, 1), (0, 0)))
    return up[:, :-2] * w[0] + up[:, 1:-1] * w[1] + up[:, 2:] * w[2] + b


def hyena_filter(L, p):
    t = jnp.linspace(0.0, 1.0, L, dtype=F32)[:, None]
    bands = (HYENA_EMB - 1) // 2
    w = 2 * math.pi * jnp.arange(L, dtype=F32)[:, None] / L
    f = jnp.linspace(1e-4, bands - 1, bands, dtype=F32)[None, :]
    z = jnp.concatenate([t, jnp.cos(f * w), -jnp.sin(f * w)], axis=-1)
    act = lambda u: jnp.sin(p["freq"] * u)
    hid = act(z @ p["f_w0"] + p["f_b0"])
    hid = act(hid @ p["f_w1"] + p["f_b1"])
    hid = act(hid @ p["f_w2"] + p["f_b2"])
    h = (hid @ p["f_wout"]).astype(F32)
    deltas = jnp.abs(jnp.linspace(HYENA_MIN_DECAY, HYENA_MAX_DECAY, D_MODEL, dtype=F32))
    window = jnp.exp(-t * deltas)
    h_fwd = h[:, :D_MODEL] * window
    h_bwd = h[:, D_MODEL:] * window
    return jnp.concatenate([h_fwd, jnp.zeros((1, D_MODEL), F32), h_bwd[:0:-1]], axis=0)


def long_conv(u, filt):
    L = u.shape[1]
    n = 2 * L
    u_f = jnp.fft.rfft(u.astype(F32), n=n, axis=1)
    f_f = jnp.fft.rfft(filt, n=n, axis=0)
    return jnp.fft.irfft(u_f * f_f[None], n=n, axis=1)[:, :L].astype(u.dtype)


def hyena_mixer(h, p):
    L = h.shape[1]
    u = centred_conv3(h @ p["in_w"] + p["in_b"], p["short_w"], p["short_b"])
    x0, x1, v = jnp.split(u, 3, axis=-1)
    v = v * x1
    v = long_conv(v, hyena_filter(L, p)) + v * p["bias"]
    return (v * x0) @ p["out_w"] + p["out_b"]


def setup_inputs(seed: int = 0) -> dict:
    key = jax.random.key(seed)
    ks = iter(jax.random.split(key, 64))
    nrm = lambda shape, std: jax.random.normal(next(ks), shape, F32) * std
    uni = lambda shape, lo, hi: jax.random.uniform(next(ks), shape, F32, lo, hi)
    D, F, H, N = D_MODEL, FFN_HIDDEN, RWKV_HEADS, RWKV_HEAD
    A, Bh, W = N_RWKV, N_HYENA, HYENA_WIDTH
    return {
        "x": nrm((BATCH, SEQ, D), 1.0),
        "c": nrm((BATCH, D), 1.0),
        "ctx": nrm((BATCH, CTX_LEN, D), 1.0),
        "c_ctx": nrm((D,), 1.0),
        "ada_w": nrm((DEPTH, D, 6 * D), D ** -0.5),
        "ada_b": nrm((DEPTH, 6 * D), 0.02),
        "norm1_g": 1.0 + nrm((DEPTH, D), 0.02),
        "norm2_g": 1.0 + nrm((DEPTH, D), 0.02),
        "ffn_w1": nrm((DEPTH, D, F), D ** -0.5),
        "ffn_w3": nrm((DEPTH, D, F), D ** -0.5),
        "ffn_w2": nrm((DEPTH, F, D), F ** -0.5),
        "rw_mu": uni((A, 6, D), 0.0, 1.0),
        "rw_w_r": nrm((A, D, D), D ** -0.5),
        "rw_w_k": nrm((A, D, D), D ** -0.5),
        "rw_w_v": nrm((A, D, D), D ** -0.5),
        "rw_w_o": nrm((A, D, D), D ** -0.5),
        "rw_w0": uni((A, 2, D), -6.0, -1.0),
        "rw_w1": nrm((A, 2, D, DECAY_LORA), D ** -0.5),
        "rw_w2": nrm((A, 2, DECAY_LORA, D), 0.1 * DECAY_LORA ** -0.5),
        "rw_a0": nrm((A, 2, D), 0.1),
        "rw_a1": nrm((A, 2, D, ICLR_LORA), D ** -0.5),
        "rw_a2": nrm((A, 2, ICLR_LORA, D), 0.1 * ICLR_LORA ** -0.5),
        "rw_g1": nrm((A, D, GATE_LORA), D ** -0.5),
        "rw_g2": nrm((A, GATE_LORA, D), GATE_LORA ** -0.5),
        "rw_k_k": 0.85 + nrm((A, D), 0.02),
        "rw_k_a": 1.0 + nrm((A, D), 0.02),
        "rw_r_k": nrm((A, H, N), 0.1),
        "rw_lnx_w": 1.0 + nrm((A, D), 0.02),
        "rw_lnx_b": nrm((A, D), 0.02),
        "hy_in_w": nrm((Bh, D, 3 * D), D ** -0.5),
        "hy_in_b": nrm((Bh, 3 * D), 0.02),
        "hy_short_w": nrm((Bh, 3, 3 * D), 3 ** -0.5),
        "hy_short_b": nrm((Bh, 3 * D), 0.02),
        "hy_f_w0": nrm((Bh, HYENA_EMB, W), HYENA_EMB ** -0.5),
        "hy_f_b0": nrm((Bh, W), 0.1),
        "hy_f_w1": nrm((Bh, W, W), W ** -0.5),
        "hy_f_b1": nrm((Bh, W), 0.1),
        "hy_f_w2": nrm((Bh, W, W), W ** -0.5),
        "hy_f_b2": nrm((Bh, W), 0.1),
        "hy_f_freq": 1.0 + nrm((Bh, W), 0.02),
        "hy_f_wout": nrm((Bh, W, 2 * D), 0.005),
        "hy_bias": nrm((Bh, D), 1.0),
        "hy_out_w": nrm((Bh, D, D), D ** -0.5),
        "hy_out_b": nrm((Bh, D), 0.02),
        "final_g": 1.0 + nrm((D,), 0.02),
    }


def reference(x, c, ctx, c_ctx, ada_w, ada_b, norm1_g, norm2_g, ffn_w1, ffn_w3, ffn_w2,
              rw_mu, rw_w_r, rw_w_k, rw_w_v, rw_w_o, rw_w0, rw_w1, rw_w2, rw_a0, rw_a1, rw_a2,
              rw_g1, rw_g2, rw_k_k, rw_k_a, rw_r_k, rw_lnx_w, rw_lnx_b,
              hy_in_w, hy_in_b, hy_short_w, hy_short_b, hy_f_w0, hy_f_b0, hy_f_w1, hy_f_b1,
              hy_f_w2, hy_f_b2, hy_f_freq, hy_f_wout, hy_bias, hy_out_w, hy_out_b, final_g):
    s_lat = jax.nn.silu(c)
    s_ctx = jax.nn.silu(c_ctx)[None]
    xl, xc = x, ctx
    for i in range(DEPTH):
        is_rwkv = i % N_MIXERS == 0
        j = i // N_MIXERS
        ctx_later = any(k % N_MIXERS == 0 for k in range(i + 1, DEPTH))
        need_ctx = is_rwkv or ctx_later
        sh1, sc1, gt1, sh2, sc2, gt2 = jnp.split((s_lat @ ada_w[i] + ada_b[i])[:, None, :], 6, axis=-1)
        hl = modulate(rms_norm(xl, norm1_g[i]), sh1, sc1)
        if need_ctx:
            csh1, csc1, cgt1, csh2, csc2, cgt2 = jnp.split((s_ctx @ ada_w[i] + ada_b[i])[:, None, :], 6, axis=-1)
            hc = modulate(rms_norm(xc, norm1_g[i]), csh1, csc1)
        if is_rwkv:
            p = {"mu": rw_mu[j], "w_r": rw_w_r[j], "w_k": rw_w_k[j], "w_v": rw_w_v[j], "w_o": rw_w_o[j],
                 "w0": rw_w0[j], "w1": rw_w1[j], "w2": rw_w2[j], "a0": rw_a0[j], "a1": rw_a1[j],
                 "a2": rw_a2[j], "g1": rw_g1[j], "g2": rw_g2[j], "k_k": rw_k_k[j], "k_a": rw_k_a[j],
                 "r_k": rw_r_k[j], "lnx_w": rw_lnx_w[j], "lnx_b": rw_lnx_b[j]}
            yl, yc = rwkv7_mixer(hc, hl, p, ctx_later)
        else:
            p = {"in_w": hy_in_w[j], "in_b": hy_in_b[j], "short_w": hy_short_w[j], "short_b": hy_short_b[j],
                 "f_w0": hy_f_w0[j], "f_b0": hy_f_b0[j], "f_w1": hy_f_w1[j], "f_b1": hy_f_b1[j],
                 "f_w2": hy_f_w2[j], "f_b2": hy_f_b2[j], "freq": hy_f_freq[j], "f_wout": hy_f_wout[j],
                 "bias": hy_bias[j], "out_w": hy_out_w[j], "out_b": hy_out_b[j]}
            yl = hyena_mixer(hl, p)
            yc = hyena_mixer(hc, p) if ctx_later else None
        xl = xl + gt1 * yl
        xl = xl + gt2 * swiglu(modulate(rms_norm(xl, norm2_g[i]), sh2, sc2), ffn_w1[i], ffn_w3[i], ffn_w2[i])
        if ctx_later:
            xc = xc + cgt1 * yc
            xc = xc + cgt2 * swiglu(modulate(rms_norm(xc, norm2_g[i]), csh2, csc2), ffn_w1[i], ffn_w3[i], ffn_w2[i])
    return rms_norm(xl, final_g)
```

```cpp
#include <hip/hip_runtime.h>
#include <hip/hip_cooperative_groups.h>
#include <cstdio>
#include <cstdint>
namespace cg = cooperative_groups;

#define LAS __attribute__((address_space(3)))
typedef unsigned short bf16_t;
typedef short bf16x8 __attribute__((ext_vector_type(8)));
typedef float f32x4 __attribute__((ext_vector_type(4)));
typedef float f32x2 __attribute__((ext_vector_type(2)));
typedef unsigned u32x4 __attribute__((ext_vector_type(4)));
typedef unsigned u32x2 __attribute__((ext_vector_type(2)));

constexpr int D = 2048, L = 8192, CT = 256, MT = L + CT, FF = 5632, NH = 32, HN = 64;
constexpr int NTHR = 512;
constexpr size_t MiB = 1u << 20;
constexpr size_t WS_MOD = 0;
constexpr size_t WS_RSTD = 256 * 1024;
constexpr size_t WS_TW1 = 320 * 1024;
constexpr size_t WS_TW2 = 384 * 1024;
constexpr size_t WS_TBL = 512 * 1024;
constexpr size_t WS_BAR = 768 * 1024;
constexpr size_t WS_HIDP = 1 * MiB;
constexpr size_t WS_WOUTP = 5 * MiB;
constexpr size_t WS_WCAT = 8 * MiB;
constexpr size_t WS_W2CAT = WS_WCAT + 27 * MiB;
constexpr size_t WS_WO = WS_W2CAT + 5 * MiB;
constexpr size_t WS_WF13_0 = WS_WO + 8 * MiB;
constexpr size_t WS_WF2_0 = WS_WF13_0 + 44 * MiB;
constexpr size_t WS_ACT = WS_WF2_0 + 22 * MiB;
constexpr size_t WS_XM = WS_ACT;
constexpr size_t XM_STRIDE = (size_t)MT * D * 2;
constexpr size_t WS_Y0 = WS_XM;
constexpr size_t WS_Y1 = WS_XM + 64 * MiB;
constexpr size_t WS_AO = WS_XM + 128 * MiB;
constexpr size_t WS_RB = WS_XM + 198 * MiB;
constexpr size_t WS_VB = WS_RB + 33 * MiB;
constexpr size_t WS_KF = WS_VB + 33 * MiB;
constexpr size_t WS_L1 = WS_KF + 66 * MiB;
constexpr size_t L1_STRIDE = (size_t)MT * 256 * 2;
constexpr size_t WS_DEC = WS_L1 + 13 * MiB;
constexpr size_t WS_ASB = WS_DEC + 132 * MiB;
constexpr size_t WS_GB = WS_ASB + 66 * MiB;
constexpr size_t WS_EARLY_END = WS_GB + 33 * MiB;
constexpr size_t WS_WHYIN = WS_XM + 160 * MiB;
constexpr size_t WS_WHYOUT = WS_WHYIN + 24 * MiB;
constexpr size_t WS_WF13_1 = WS_EARLY_END;
constexpr size_t WS_WF2_1 = WS_WF13_1 + 44 * MiB;
constexpr size_t WS_A2 = WS_ACT;
constexpr size_t WS_VVT = WS_ACT + 32 * MiB;
constexpr size_t WS_X0T = WS_VVT + 64 * MiB;
constexpr size_t WS_UPRE = WS_WHYOUT + 8 * MiB;
constexpr size_t WS_HID = WS_UPRE;
constexpr size_t WS_ZT = WS_UPRE;
constexpr size_t WS_FILT = WS_UPRE + 192 * MiB;
constexpr size_t WS_LATE_END = WS_WF2_1 + 22 * MiB;
static_assert(WS_X0T + 64 * MiB <= WS_WHYIN && WS_FILT + 128 * MiB <= WS_WF13_1, "late layout overlap");
constexpr size_t WS_NEED = WS_LATE_END > WS_EARLY_END ? WS_LATE_END : WS_EARLY_END;

#ifndef REPMASK
#define REPMASK 0u
#endif
constexpr int XB_LDS_OFF = 153600, LDS_TOTAL = 153856;
struct Args { const float* in[45]; float* out; unsigned char* ws; };

__device__ __forceinline__ unsigned pk2(float lo, float hi) { unsigned r; asm volatile("s_nop 1\n\tv_cvt_pk_bf16_f32 %0, %1, %2" : "=v"(r) : "v"(lo), "v"(hi)); return r; }
__device__ __forceinline__ bf16_t f2bf(float f) { unsigned u = __float_as_uint(f); u += 0x7FFFu + ((u >> 16) & 1u); return (bf16_t)(u >> 16); }
__device__ __forceinline__ float bf2f(unsigned b) { return __uint_as_float(b << 16); }
__device__ __forceinline__ float bflo(unsigned w) { return __uint_as_float(w << 16); }
__device__ __forceinline__ float bfhi(unsigned w) { return __uint_as_float(w & 0xFFFF0000u); }
__device__ __forceinline__ float wave_sum(float v) {
#pragma unroll
    for (int o = 1; o < 64; o <<= 1) v += __shfl_xor(v, o);
    return v;
}
template <int CTRL> __device__ __forceinline__ float dpp(float x) { return __builtin_bit_cast(float, __builtin_amdgcn_mov_dpp(__builtin_bit_cast(int, x), CTRL, 0xf, 0xf, true)); }
__device__ __forceinline__ float red16(float x) {
    x += dpp<0xB1>(x); x += dpp<0x4E>(x); x += dpp<0x141>(x); x += dpp<0x128>(x); return x;
}
__device__ __forceinline__ float sigmoidf_(float x) { return __builtin_amdgcn_rcpf(1.f + __expf(-x)); }
__device__ __forceinline__ float tanhf_(float x) { return 1.f - 2.f * __builtin_amdgcn_rcpf(1.f + __expf(2.f * x)); }
__device__ __forceinline__ const float* ldp_(const unsigned long long* tbl, int k) {
    const unsigned long long v = ((const volatile unsigned long long*)tbl)[k];
    const unsigned lo = __builtin_amdgcn_readfirstlane((unsigned)v), hi = __builtin_amdgcn_readfirstlane((unsigned)(v >> 32));
    return (const float*)(((unsigned long long)hi << 32) | lo);
}
__device__ __forceinline__ int otid() { int t = threadIdx.x; asm volatile("" : "+v"(t)); return t; }
#define LDS_WAIT() asm volatile("s_waitcnt lgkmcnt(0)" ::: "memory")

namespace pg8 {
constexpr int BM = 256, BK = 64, HALF = 128, HTB = HALF * BK * 2, STAGE_BYTES = 8 * HTB, NXCD = 8, WGM = 8;
__device__ __forceinline__ int lds_byte(int r, int c) { const int st = (r >> 4) * 2 + (c >> 5), rr = r & 15, cc = c & 31, ob = rr * 64 + cc * 2; return st * 1024 + (ob ^ (((ob >> 9) & 1) << 5)); }
__device__ __forceinline__ void stage_rc(int b, int& R, int& C) { const int st = b / 1024, sb = b % 1024, swz = sb ^ (((sb >> 9) & 1) << 5); R = (st >> 1) * 16 + swz / 64; C = (st & 1) * 32 + (swz % 64) / 2; }
__device__ __forceinline__ int perm32(int rho) { const int n = rho >> 4, i = rho & 15; return 8 * (i >> 2) + 4 * n + (i & 3); }
struct Unit { int pm, pn; };
struct Gemm { const bf16_t* A; const bf16_t* Bt; int M, N, K; int amode; size_t astride; };
__device__ __forceinline__ int aidx(int amode, int pn) { return amode == 0 ? 0 : (amode == 1 ? (pn < 8 ? 0 : (pn < 16 ? 2 : (pn < 24 ? 3 : (pn == 24 ? 1 : (pn == 25 ? 4 : 5))))) : (pn < 16 ? 0 : (pn < 32 ? 1 : 2))); }
struct StaticOrder {
    int nM, nN, nwg, G, c;
    __device__ void init(int M, int N, int G_, int c_) { nM = M / BM; nN = N / BM; nwg = nM * nN; G = G_; c = c_; }
    __device__ bool next(int i, Unit& u) const {
        const long Lx = (long)i * G + c; if (Lx >= nwg) return false;
        int wgid = (int)Lx; { const int q = nwg / NXCD, r = nwg % NXCD, xcd = wgid % NXCD, off = wgid / NXCD; wgid = (xcd < r ? xcd * (q + 1) : r * (q + 1) + (xcd - r) * q) + off; }
        const int nig = WGM * nN, gid = wgid / nig, fm = gid * WGM, gsz = (nM - fm) < WGM ? (nM - fm) : WGM;
        u.pm = fm + ((wgid % nig) % gsz); u.pn = (wgid % nig) / gsz; return true;
    }
};
__device__ __forceinline__ u32x4 pack8(f32x4 v0, f32x4 v1) { u32x4 w; w.x = pk2(v0[0], v0[1]); w.y = pk2(v0[2], v0[3]); w.z = pk2(v1[0], v1[1]); w.w = pk2(v1[2], v1[3]); return w; }

struct EpiP2 {
    static constexpr bool PERM = true;
    bf16_t* RB; float* KF; bf16_t* VB; bf16_t* L1;
    __device__ __forceinline__ void operator()(const f32x4 (&acc)[2][2][4][2], const Unit& u, int wr, int wc, int fr, int fq) const {
        const int row0 = u.pm * BM + wr * 64 + fr; const int pn = u.pn;
        if (pn >= 8 && pn < 16) {
            const int col0 = (pn - 8) * BM + wc * 32 + 8 * fq;
#pragma unroll
            for (int ai = 0; ai < 2; ++ai)
#pragma unroll
                for (int m = 0; m < 4; ++m) { float* rowp = KF + (size_t)(row0 + ai * HALF + m * 16) * D + col0;
#pragma unroll
                    for (int bj = 0; bj < 2; ++bj)
#pragma unroll
                        for (int n = 0; n < 2; ++n) *(f32x4*)(rowp + bj * HALF + 4 * n) = acc[ai][bj][m][n]; }
        } else if (pn < 24) {
            bf16_t* base = pn < 8 ? RB : VB; const int col0 = (pn & 7) * BM + wc * 32 + 8 * fq;
#pragma unroll
            for (int ai = 0; ai < 2; ++ai)
#pragma unroll
                for (int m = 0; m < 4; ++m) { bf16_t* rowp = base + (size_t)(row0 + ai * HALF + m * 16) * D + col0;
#pragma unroll
                    for (int bj = 0; bj < 2; ++bj) *(u32x4*)(rowp + bj * HALF) = pack8(acc[ai][bj][m][0], acc[ai][bj][m][1]); }
        } else {
            const int which = pn - 24; bf16_t* base = L1 + (size_t)which * ((size_t)MT * 256); const int col0 = wc * 32 + 8 * fq;
#pragma unroll
            for (int ai = 0; ai < 2; ++ai)
#pragma unroll
                for (int m = 0; m < 4; ++m) { bf16_t* rowp = base + (size_t)(row0 + ai * HALF + m * 16) * 256 + col0;
#pragma unroll
                    for (int bj = 0; bj < 2; ++bj) { f32x4 v0 = acc[ai][bj][m][0], v1 = acc[ai][bj][m][1];
                        if (which == 0) {
#pragma unroll
                            for (int j = 0; j < 4; ++j) { v0[j] = tanhf_(v0[j]); v1[j] = tanhf_(v1[j]); }
                        } else if (which == 2) {
#pragma unroll
                            for (int j = 0; j < 4; ++j) { v0[j] = sigmoidf_(v0[j]); v1[j] = sigmoidf_(v1[j]); }
                        }
                        *(u32x4*)(rowp + bj * HALF) = pack8(v0, v1); } }
        }
    }
};
struct EpiP3 {
    static constexpr bool PERM = true;
    float* DEC; bf16_t* ASB; bf16_t* GB; const float* w0; const float* a0;
    __device__ __forceinline__ void operator()(const f32x4 (&acc)[2][2][4][2], const Unit& u, int wr, int wc, int fr, int fq) const {
        const int row0 = u.pm * BM + wr * 64 + fr; const int pn = u.pn;
        if (pn < 16) {
            const int col0 = pn * BM + wc * 32 + 8 * fq;
#pragma unroll
            for (int bj = 0; bj < 2; ++bj)
#pragma unroll
                for (int n = 0; n < 2; ++n) { const int c = col0 + bj * HALF + 4 * n; const f32x4 wb = *(const f32x4*)(w0 + c);
#pragma unroll
                    for (int ai = 0; ai < 2; ++ai)
#pragma unroll
                        for (int m = 0; m < 4; ++m) { f32x4 v = acc[ai][bj][m][n] + wb;
#pragma unroll
                            for (int j = 0; j < 4; ++j) { const float x = v[j];
                                const float sp = fmaxf(-x, 0.f) + __logf(1.f + __expf(-fabsf(x))); v[j] = __expf(-__expf(-sp - 0.5f)); }
                            *(f32x4*)(DEC + (size_t)(row0 + ai * HALF + m * 16) * 4096 + c) = v; } }
        } else if (pn < 32) {
            const int col0 = (pn - 16) * BM + wc * 32 + 8 * fq;
#pragma unroll
            for (int bj = 0; bj < 2; ++bj) { const int c = col0 + bj * HALF; const f32x4 b0 = *(const f32x4*)(a0 + c), b1 = *(const f32x4*)(a0 + c + 4);
#pragma unroll
                for (int ai = 0; ai < 2; ++ai)
#pragma unroll
                    for (int m = 0; m < 4; ++m) { f32x4 v0 = acc[ai][bj][m][0] + b0, v1 = acc[ai][bj][m][1] + b1;
#pragma unroll
                        for (int j = 0; j < 4; ++j) { v0[j] = sigmoidf_(v0[j]); v1[j] = sigmoidf_(v1[j]); }
                        *(u32x4*)(ASB + (size_t)(row0 + ai * HALF + m * 16) * 4096 + c) = pack8(v0, v1); } }
        } else {
            const int col0 = (pn - 32) * BM + wc * 32 + 8 * fq;
#pragma unroll
            for (int ai = 0; ai < 2; ++ai)
#pragma unroll
                for (int m = 0; m < 4; ++m) { bf16_t* rowp = GB + (size_t)(row0 + ai * HALF + m * 16) * D + col0;
#pragma unroll
                    for (int bj = 0; bj < 2; ++bj) *(u32x4*)(rowp + bj * HALF) = pack8(acc[ai][bj][m][0], acc[ai][bj][m][1]); }
        }
    }
};
struct EpiF32B {
    static constexpr bool PERM = false;
    float* C; int ldc; const float* bias;
    __device__ __forceinline__ void operator()(const f32x4 (&acc)[2][2][4][2], const Unit& u, int wr, int wc, int fr, int fq) const {
        const int row0 = u.pm * BM + wr * 64 + fr, col0 = u.pn * BM + wc * 32 + 4 * fq;
#pragma unroll
        for (int bj = 0; bj < 2; ++bj)
#pragma unroll
            for (int n = 0; n < 2; ++n) { const int c = col0 + bj * HALF + n * 16; const f32x4 bv = *(const f32x4*)(bias + c);
#pragma unroll
                for (int ai = 0; ai < 2; ++ai)
#pragma unroll
                    for (int m = 0; m < 4; ++m) *(f32x4*)(C + (size_t)(row0 + ai * HALF + m * 16) * ldc + c) = acc[ai][bj][m][n] + bv; }
    }
};
struct EpiBf16B {
    static constexpr bool PERM = true;
    bf16_t* O; int ldc; const float* bias;
    __device__ __forceinline__ void operator()(const f32x4 (&acc)[2][2][4][2], const Unit& u, int wr, int wc, int fr, int fq) const {
        const int row0 = u.pm * BM + wr * 64 + fr, col0 = u.pn * BM + wc * 32 + 8 * fq;
#pragma unroll
        for (int bj = 0; bj < 2; ++bj) { const int c = col0 + bj * HALF; const f32x4 b0 = *(const f32x4*)(bias + c), b1 = *(const f32x4*)(bias + c + 4);
#pragma unroll
            for (int ai = 0; ai < 2; ++ai)
#pragma unroll
                for (int m = 0; m < 4; ++m) *(u32x4*)(O + (size_t)(row0 + ai * HALF + m * 16) * ldc + c) = pack8(acc[ai][bj][m][0] + b0, acc[ai][bj][m][1] + b1); }
    }
};
struct EpiFilt {
    static constexpr bool PERM = false;
    float* F;
    __device__ __forceinline__ void operator()(const f32x4 (&acc)[2][2][4][2], const Unit& u, int wr, int wc, int fr, int fq) const {
        const int row0 = u.pm * BM + wr * 64 + fr, col0 = u.pn * BM + wc * 32 + 4 * fq;
        const float dmin = -3.0701134573253944f, dmax = -15.350567286626972f;
#pragma unroll
        for (int ai = 0; ai < 2; ++ai)
#pragma unroll
            for (int m = 0; m < 4; ++m) { const int r = row0 + ai * HALF + m * 16; const int ch = r & 2047;
                const float delta = fabsf(dmin + (float)ch * ((dmax - dmin) / 2047.f));
#pragma unroll
                for (int bj = 0; bj < 2; ++bj)
#pragma unroll
                    for (int n = 0; n < 2; ++n) { const int c = col0 + bj * HALF + n * 16; f32x4 v = acc[ai][bj][m][n];
#pragma unroll
                        for (int j = 0; j < 4; ++j) v[j] *= __expf(-((float)(c + j) * (1.f / 8191.f)) * delta);
                        *(f32x4*)(F + (size_t)r * L + c) = v; } }
    }
};
struct EpiRes {
    static constexpr bool PERM = false;
    const float* res; float* out; const float* gate; const float* bias;
    __device__ __forceinline__ void operator()(const f32x4 (&acc)[2][2][4][2], const Unit& u, int wr, int wc, int fr, int fq) const {
        const int row0 = u.pm * BM + wr * 64 + fr, col0 = u.pn * BM + wc * 32 + 4 * fq;
#pragma unroll
        for (int bj = 0; bj < 2; ++bj)
#pragma unroll
            for (int n = 0; n < 2; ++n) { const int c = col0 + bj * HALF + n * 16; const f32x4 gv = *(const f32x4*)(gate + c);
                f32x4 bv = (f32x4){0.f, 0.f, 0.f, 0.f}; if (bias) bv = *(const f32x4*)(bias + c);
#pragma unroll
                for (int ai = 0; ai < 2; ++ai)
#pragma unroll
                    for (int m = 0; m < 4; ++m) { const size_t o = (size_t)(row0 + ai * HALF + m * 16) * D + c;
                        const f32x4 rv = *(const f32x4*)(res + o); *(f32x4*)(out + o) = rv + gv * (acc[ai][bj][m][n] + bv); } }
    }
};
struct EpiSwi {
    static constexpr bool PERM = true;
    bf16_t* H;
    __device__ __forceinline__ void operator()(const f32x4 (&acc)[2][2][4][2], const Unit& u, int wr, int wc, int fr, int fq) const {
        const int row0 = u.pm * BM + wr * 64 + fr, col0 = u.pn * HALF + wc * 32 + 8 * fq;
#pragma unroll
        for (int ai = 0; ai < 2; ++ai)
#pragma unroll
            for (int m = 0; m < 4; ++m) { f32x4 v0, v1;
#pragma unroll
                for (int j = 0; j < 4; ++j) { const float a0 = acc[ai][0][m][0][j], a1 = acc[ai][0][m][1][j];
                    v0[j] = a0 * sigmoidf_(a0) * acc[ai][1][m][0][j]; v1[j] = a1 * sigmoidf_(a1) * acc[ai][1][m][1][j]; }
                *(u32x4*)(H + (size_t)(row0 + ai * HALF + m * 16) * FF + col0) = pack8(v0, v1); }
    }
};

template <class Epi>
__device__ __forceinline__ void gemm_phase(LAS unsigned char* lds, const Gemm g, const StaticOrder& S, const Epi& E) {
    const int tid = otid(), wid = __builtin_amdgcn_readfirstlane(tid >> 6), lane = tid & 63, wr = wid >> 2, wc = wid & 3, fr = lane & 15, fq = lane >> 4;
    const int K = g.K, nt = K / BK;
    unsigned voffA[2], voffB[2];
#pragma unroll
    for (int i = 0; i < 2; ++i) { int R, C; stage_rc(tid * 16 + i * 8192, R, C); const int Rb = Epi::PERM ? ((R & ~31) + perm32(R & 31)) : R;
        voffA[i] = (unsigned)(R * K + C) * 2u; voffB[i] = (unsigned)(Rb * K + C) * 2u; }
    const size_t kstep = (size_t)(BK * 2);
    const size_t hstep = (size_t)HALF * K * 2;
    const size_t tstep = 2 * hstep;
    const unsigned ldsw = (unsigned)wid * 1024u;
    const int aoff = lds_byte(wr * 64 + fr, fq * 8), boff = lds_byte(wc * 32 + fr, fq * 8);
#define PG8_SA(b, h) (((b) * 2 + (h)) * HTB)
#define PG8_SB(b, h) ((4 + (b) * 2 + (h)) * HTB)
#define PG8_STAGE(bufoff, gbase, voff) do { _Pragma("unroll") for (int _i = 0; _i < 2; ++_i) \
        __builtin_amdgcn_global_load_lds((const unsigned*)((const char*)(gbase) + (voff)[_i]), (LAS unsigned*)(lds + (bufoff) + ldsw + _i * 8192), 16, 0, 0); } while (0)
#define PG8_LDA(dst, b, h) do { _Pragma("unroll") for (int m = 0; m < 4; ++m) _Pragma("unroll") for (int k = 0; k < 2; ++k) dst[m][k] = *(const LAS bf16x8*)(lds + PG8_SA(b, h) + aoff + m * 2048 + k * 1024); } while (0)
#define PG8_LDB(dst, b, h) do { _Pragma("unroll") for (int n = 0; n < 2; ++n) _Pragma("unroll") for (int k = 0; k < 2; ++k) dst[n][k] = *(const LAS bf16x8*)(lds + PG8_SB(b, h) + boff + n * 2048 + k * 1024); } while (0)
#define PG8_MMA(ai, bj, At, Bt) do { __builtin_amdgcn_s_setprio(1); _Pragma("unroll") for (int m = 0; m < 4; ++m) _Pragma("unroll") for (int n = 0; n < 2; ++n) _Pragma("unroll") for (int k = 0; k < 2; ++k) \
        acc[ai][bj][m][n] = __builtin_amdgcn_mfma_f32_16x16x32_bf16(Bt[n][k], At[m][k], acc[ai][bj][m][n], 0, 0, 0); __builtin_amdgcn_s_setprio(0); } while (0)
#define PG8_WAIT_V(n) asm volatile("s_waitcnt vmcnt(" #n ")" ::: "memory")
#define PG8_WAIT_L(n) asm volatile("s_waitcnt lgkmcnt(" #n ")" ::: "memory")
#define PG8_BAR __builtin_amdgcn_s_barrier()
#define PG8_SCHED __builtin_amdgcn_sched_barrier(0)
    Unit cur, nxt; int ui = 0;
    if (!S.next(0, cur)) return;
    f32x4 acc[2][2][4][2];
#pragma unroll
    for (int a = 0; a < 2; ++a)
#pragma unroll
        for (int b = 0; b < 2; ++b)
#pragma unroll
            for (int m = 0; m < 4; ++m)
#pragma unroll
                for (int n = 0; n < 2; ++n) acc[a][b][m][n] = (f32x4){0.f, 0.f, 0.f, 0.f};
    bf16x8 At[4][2], B0[2][2], B1[2][2];
    const char* cA = (const char*)g.A + (size_t)aidx(g.amode, cur.pn) * g.astride + (size_t)cur.pm * tstep; const char* cB = (const char*)g.Bt + (size_t)cur.pn * tstep;
    PG8_STAGE(PG8_SB(0, 0), cB, voffB); PG8_STAGE(PG8_SA(0, 0), cA, voffA); PG8_STAGE(PG8_SB(0, 1), cB + hstep, voffB); PG8_STAGE(PG8_SA(0, 1), cA + hstep, voffA);
    if (wr == 1) PG8_BAR;
    PG8_WAIT_V(4); PG8_BAR;
    PG8_STAGE(PG8_SB(1, 0), cB + kstep, voffB); PG8_STAGE(PG8_SA(1, 0), cA + kstep, voffA); PG8_STAGE(PG8_SB(1, 1), cB + hstep + kstep, voffB);
    PG8_WAIT_V(6); PG8_BAR;
    for (;;) {
        const bool has_next = S.next(ui + 1, nxt);
        const char* nA = has_next ? (const char*)g.A + (size_t)aidx(g.amode, nxt.pn) * g.astride + (size_t)nxt.pm * tstep : cA; const char* nB = has_next ? (const char*)g.Bt + (size_t)nxt.pn * tstep : cB;
        for (int t = 0; t < nt; t += 2) {
            const bool last = (t == nt - 2);
            const char* a1 = cA + (size_t)(t + 1) * kstep;
            const char* a2 = last ? nA : cA + (size_t)(t + 2) * kstep; const char* b2 = last ? nB : cB + (size_t)(t + 2) * kstep;
            const char* a3 = a2 + kstep; const char* b3 = b2 + kstep;
            PG8_LDB(B0, 0, 0); PG8_SCHED; PG8_LDA(At, 0, 0); PG8_STAGE(PG8_SA(1, 1), a1 + hstep, voffA);
            PG8_WAIT_L(8); PG8_BAR; PG8_WAIT_L(0); PG8_MMA(0, 0, At, B0); PG8_BAR; PG8_SCHED;
            PG8_LDB(B1, 0, 1); PG8_STAGE(PG8_SB(0, 0), b2, voffB);
            PG8_BAR; PG8_WAIT_L(0); PG8_MMA(0, 1, At, B1); PG8_BAR;
            PG8_LDA(At, 0, 1); PG8_STAGE(PG8_SA(0, 0), a2, voffA);
            PG8_BAR; PG8_WAIT_L(0); PG8_MMA(1, 0, At, B0); PG8_BAR; PG8_SCHED;
            PG8_STAGE(PG8_SB(0, 1), b2 + hstep, voffB);
            PG8_WAIT_V(6); PG8_BAR; PG8_MMA(1, 1, At, B1); PG8_BAR;
            PG8_LDB(B0, 1, 0); PG8_SCHED; PG8_LDA(At, 1, 0); PG8_STAGE(PG8_SA(0, 1), a2 + hstep, voffA);
            PG8_WAIT_L(8); PG8_BAR; PG8_WAIT_L(0); PG8_MMA(0, 0, At, B0); PG8_BAR; PG8_SCHED;
            PG8_LDB(B1, 1, 1); PG8_STAGE(PG8_SB(1, 0), b3, voffB);
            PG8_BAR; PG8_WAIT_L(0); PG8_MMA(0, 1, At, B1); PG8_BAR;
            PG8_LDA(At, 1, 1); PG8_STAGE(PG8_SA(1, 0), a3, voffA);
            PG8_BAR; PG8_WAIT_L(0); PG8_MMA(1, 0, At, B0); PG8_BAR; PG8_SCHED;
            PG8_STAGE(PG8_SB(1, 1), b3 + hstep, voffB);
            PG8_WAIT_V(6); PG8_BAR; PG8_MMA(1, 1, At, B1); PG8_BAR;
        }
        E(acc, cur, wr, wc, fr, fq);
        if (!has_next) break;
#pragma unroll
        for (int a = 0; a < 2; ++a)
#pragma unroll
            for (int b = 0; b < 2; ++b)
#pragma unroll
                for (int m = 0; m < 4; ++m)
#pragma unroll
                    for (int n = 0; n < 2; ++n) acc[a][b][m][n] = (f32x4){0.f, 0.f, 0.f, 0.f};
        cur = nxt; cA = nA; cB = nB; ++ui;
    }
    PG8_WAIT_V(0);
    if (wr == 0) PG8_BAR;
    PG8_BAR;
#undef PG8_SA
#undef PG8_SB
#undef PG8_STAGE
#undef PG8_LDA
#undef PG8_LDB
#undef PG8_MMA
#undef PG8_WAIT_V
#undef PG8_WAIT_L
#undef PG8_BAR
#undef PG8_SCHED
}
}

__device__ __forceinline__ void transpose_load(const float* W, int ldw, int k0, int n0, int lane, float (&tv)[32]) {
    const float* wp = W + (size_t)(k0 + (lane >> 5)) * ldw + n0 + (lane & 31);
#pragma unroll
    for (int i = 0; i < 32; ++i) tv[i] = __builtin_nontemporal_load(wp + (size_t)(2 * i) * ldw);
}
__device__ __forceinline__ void transpose_finish(bf16_t* WT, int ldt, int drow0, int dcol0, LAS float* scr, int lane, const float (&tv)[32]) {
#pragma unroll
    for (int i = 0; i < 32; ++i) scr[(2 * i + (lane >> 5)) * 33 + (lane & 31)] = tv[i];
    LDS_WAIT();
    const int c = lane & 7;
#pragma unroll
    for (int j = 0; j < 4; ++j) { const int n = (lane >> 3) + 8 * j; const LAS float* s = scr + (8 * c) * 33 + n;
        u32x4 o; o.x = pk2(s[0 * 33], s[1 * 33]); o.y = pk2(s[2 * 33], s[3 * 33]); o.z = pk2(s[4 * 33], s[5 * 33]); o.w = pk2(s[6 * 33], s[7 * 33]);
        *(u32x4*)(WT + (size_t)(drow0 + n) * ldt + dcol0 + 8 * c) = o; }
    LDS_WAIT();
}
__device__ __forceinline__ void transpose_item(const float* W, int ldw, bf16_t* WT, int ldt, int k0, int n0, int drow0, int dcol0, LAS float* scr, int lane) {
    float tv[32];
    transpose_load(W, ldw, k0, n0, lane, tv);
    transpose_finish(WT, ldt, drow0, dcol0, scr, lane, tv);
}
__device__ __forceinline__ void transpose_mat(const float* W, int N, bf16_t* WT, int ldt, int rowmode, int row_off, int it, LAS float* scr, int lane) {
    const int nblk = N / 32, kb = it / nblk, nb = it % nblk, k0 = 64 * kb, n0 = 32 * nb;
    const int drow0 = rowmode == 0 ? row_off + n0 : (n0 >> 7) * 256 + (n0 & 127) + row_off;
    transpose_item(W, N, WT, ldt, k0, n0, drow0, k0, scr, lane);
}


#define XB_TMO      128
#define XB_XCNT(j)  (256  + 64 * (j))
#define XB_XSUB(j)  (1280 + 64 * (j))
#define XB_XGEN(j)  (2304 + 64 * (j))
#define XB_TOP      3328
#define XB_TOPGEN   3392
#define XCD_BAR_WORDS 3456
#define XB_SPIN_CAP (1u << 18)
__device__ __forceinline__ unsigned xb_ld(unsigned* p)              { return __hip_atomic_load(p, __ATOMIC_RELAXED, __HIP_MEMORY_SCOPE_AGENT); }
__device__ __forceinline__ unsigned xb_add(unsigned* p, unsigned v) { return __hip_atomic_fetch_add(p, v, __ATOMIC_RELAXED, __HIP_MEMORY_SCOPE_AGENT); }
__device__ __forceinline__ unsigned xb_xcc_id() { return (unsigned)__builtin_amdgcn_s_getreg((3 << 11) | 20) & 0xFu; }
#define XB_SPIN(cond, bar) do { unsigned _sp = 0; while (cond) { __builtin_amdgcn_s_sleep(1); \
    if ((++_sp & 255u) == 0u) { if (xb_ld(&(bar)[XB_TMO])) break; if (_sp > XB_SPIN_CAP) { atomicAdd(&(bar)[XB_TMO], 1u); break; } } } } while (0)
struct XcdBarrier { unsigned* bar; unsigned x; volatile LAS unsigned* st; };
__device__ __forceinline__ XcdBarrier xcd_barrier_post(unsigned* bar, volatile LAS unsigned* st) {
    XcdBarrier b; b.bar = bar; b.x = xb_xcc_id(); b.st = st;
    if (threadIdx.x == 0) (void)xb_add(&bar[XB_XCNT(b.x)], 1u);
    return b;
}
__device__ __forceinline__ void xcd_barrier_complete(unsigned* bar, unsigned x, unsigned& nloc, unsigned& nx) {
    const unsigned Gt = gridDim.x * gridDim.y * gridDim.z;
    unsigned sum, cnt, mine, sp = 0u;
    for (;;) {
        sum = 0u; cnt = 0u; mine = 0u;
#pragma unroll
        for (unsigned j = 0; j < 16; ++j) { const unsigned c = xb_ld(&bar[XB_XCNT(j)]); sum += c; cnt += (c > 0u) ? 1u : 0u; mine = (j == x) ? c : mine; }
        if (sum == Gt) break;
        __builtin_amdgcn_s_sleep(1);
        if ((++sp & 255u) == 0u) { if (xb_ld(&bar[XB_TMO])) break; if (sp > XB_SPIN_CAP) { atomicAdd(&bar[XB_TMO], 1u); break; } }
    }
    nloc = mine > 0u ? mine : 1u; nx = cnt > 0u ? cnt : 1u;
}
__device__ __forceinline__ void xcd_barrier(const XcdBarrier& b) {
    asm volatile("s_waitcnt vmcnt(0)" ::: "memory");
    __syncthreads();
    if (threadIdx.x == 0) {
        unsigned* bar = b.bar;
        __builtin_amdgcn_s_waitcnt(0);
        unsigned nloc = b.st[0], nx = b.st[1];
        if (nloc == 0u) { xcd_barrier_complete(bar, b.x, nloc, nx); b.st[0] = nloc; b.st[1] = nx; }
        const unsigned old = xb_add(&bar[XB_XSUB(b.x)], 1u);
        const unsigned gen = old / nloc;
        if (old + 1u == (gen + 1u) * nloc) {
            __builtin_amdgcn_fence(__ATOMIC_RELEASE, "agent");
            asm volatile("s_waitcnt vmcnt(0)" ::: "memory");
            const unsigned og = xb_add(&bar[XB_TOP], 1u);
            const unsigned tg = og / nx;
            if (og + 1u == (tg + 1u) * nx) xb_add(&bar[XB_TOPGEN], 1u);
            else XB_SPIN(xb_ld(&bar[XB_TOPGEN]) == tg, bar);
            __builtin_amdgcn_fence(__ATOMIC_ACQUIRE, "agent");
            xb_add(&bar[XB_XGEN(b.x)], 1u);
            asm volatile("s_waitcnt vmcnt(0)" ::: "memory");
        } else {
            XB_SPIN(xb_ld(&bar[XB_XGEN(b.x)]) == gen, bar);
            __builtin_amdgcn_fence(__ATOMIC_ACQUIRE, "agent");
            asm volatile("s_waitcnt vmcnt(0)" ::: "memory");
        }
    }
    __syncthreads();
}

__global__ void __launch_bounds__(NTHR, 2) mega(Args a) {
    extern __shared__ __attribute__((aligned(16))) unsigned char lds_raw[];
    cg::grid_group grid = cg::this_grid();
    LAS unsigned char* lds = (LAS unsigned char*)lds_raw;
    LAS float* smf = (LAS float*)lds_raw;
    const int G = gridDim.x, bid = blockIdx.x, NGW = G * 8;
    const size_t GT = (size_t)G * NTHR;
#define PH_VARS const int tid = otid(), lane = tid & 63, wave = __builtin_amdgcn_readfirstlane(tid >> 6); const int gw = bid * 8 + wave; const size_t gtid = (size_t)bid * NTHR + tid; (void)lane; (void)gw; (void)gtid; (void)wave;
#define MOD ((float*)(a.ws + WS_MOD))
#define RSTD ((float*)(a.ws + WS_RSTD))
#define TW1 ((f32x2*)(a.ws + WS_TW1))
#define TW2 ((f32x2*)(a.ws + WS_TW2))
#define HIDP ((bf16_t*)(a.ws + WS_HIDP))
#define WOUTP ((bf16_t*)(a.ws + WS_WOUTP))
#define WCAT ((bf16_t*)(a.ws + WS_WCAT))
#define W2CAT ((bf16_t*)(a.ws + WS_W2CAT))
#define WO ((bf16_t*)(a.ws + WS_WO))
#define WF13_0 ((bf16_t*)(a.ws + WS_WF13_0))
#define WF2_0 ((bf16_t*)(a.ws + WS_WF2_0))
#define XM ((bf16_t*)(a.ws + WS_XM))
#define Y0 ((bf16_t*)(a.ws + WS_Y0))
#define Y1 ((bf16_t*)(a.ws + WS_Y1))
#define AO ((bf16_t*)(a.ws + WS_AO))
#define RB ((bf16_t*)(a.ws + WS_RB))
#define VB ((bf16_t*)(a.ws + WS_VB))
#define KF ((float*)(a.ws + WS_KF))
#define L1B ((bf16_t*)(a.ws + WS_L1))
#define DEC ((float*)(a.ws + WS_DEC))
#define ASB ((bf16_t*)(a.ws + WS_ASB))
#define GB ((bf16_t*)(a.ws + WS_GB))
#define WHYIN ((bf16_t*)(a.ws + WS_WHYIN))
#define WHYOUT ((bf16_t*)(a.ws + WS_WHYOUT))
#define WF13_1 ((bf16_t*)(a.ws + WS_WF13_1))
#define WF2_1 ((bf16_t*)(a.ws + WS_WF2_1))
#define A2 ((bf16_t*)(a.ws + WS_A2))
#define UPRE ((bf16_t*)(a.ws + WS_UPRE))
#define HID ((bf16_t*)(a.ws + WS_HID))
#define ZT ((float*)(a.ws + WS_ZT))
#define FILT ((float*)(a.ws + WS_FILT))
#define VVT ((float*)(a.ws + WS_VVT))
#define X0T ((float*)(a.ws + WS_X0T))
#define XL (a.out)
#define IN(k) ldp_(tbl, k)

    volatile LAS unsigned* xb_st = (volatile LAS unsigned*)(lds_raw + XB_LDS_OFF);
    if (threadIdx.x < 4) xb_st[threadIdx.x] = 0u;
    __syncthreads();
    const XcdBarrier xbar = xcd_barrier_post((unsigned*)(a.ws + WS_BAR), xb_st);
#define GRID_BAR() xcd_barrier(xbar)
    unsigned long long* tbl = (unsigned long long*)(a.ws + WS_TBL) + (size_t)blockIdx.x * 64;
    if (threadIdx.x == 0) {
#pragma unroll
        for (int i = 0; i < 45; ++i) tbl[i] = (unsigned long long)a.in[i];
    }
    __syncthreads();
    for (int rep_ = 0; rep_ < 1 + (int)((REPMASK >> 0) & 1u); ++rep_) { PH_VARS
        const float* cv = IN(1); const float* ccv = IN(3); const float* W = IN(4); const float* Bv = IN(5);
        for (int i = tid; i < D; i += NTHR) { const float v = cv[i]; smf[i] = v / (1.f + expf(-v)); const float w = ccv[i]; smf[D + i] = w / (1.f + expf(-w)); }
        __syncthreads();
        LAS float* red = smf + 2 * D;
        for (int cb = bid; cb < 256; cb += G) {
            const int col0 = cb * 48, c4 = tid % 12, rg = tid / 12;
            if (rg < 42) {
                f32x4 aL0 = (f32x4){0.f, 0.f, 0.f, 0.f}, aC0 = aL0, aL1 = aL0;
                const float* w0p = W + col0 + 4 * c4; const float* w1p = W + (size_t)D * 12288 + col0 + 4 * c4;
#pragma unroll 6
                for (int r = rg; r < D; r += 42) {
                    const f32x4 x0 = *(const f32x4*)(w0p + (size_t)r * 12288), x1 = *(const f32x4*)(w1p + (size_t)r * 12288);
                    const float sl = smf[r], sc = smf[D + r];
                    aL0 += x0 * sl; aC0 += x0 * sc; aL1 += x1 * sl;
                }
#pragma unroll
                for (int j = 0; j < 4; ++j) { red[(0 * 42 + rg) * 48 + 4 * c4 + j] = aL0[j]; red[(1 * 42 + rg) * 48 + 4 * c4 + j] = aC0[j]; red[(2 * 42 + rg) * 48 + 4 * c4 + j] = aL1[j]; }
            }
            __syncthreads();
            if (tid < 144) { const int which = tid / 48, cl = tid % 48; float s = 0.f;
                for (int q = 0; q < 42; ++q) s += red[(which * 42 + q) * 48 + cl];
                s += Bv[(which == 2 ? 12288 : 0) + col0 + cl]; MOD[which * 12288 + col0 + cl] = s; }
            __syncthreads();
        }
    }
    for (int rep_ = 0; rep_ < 1 + (int)((REPMASK >> 0) & 1u); ++rep_) { PH_VARS
        const float* xin_ = IN(0); const float* cin_ = IN(2);
        for (int r = gw; r < MT; r += NGW) { const float* src = r < L ? xin_ + (size_t)r * D : cin_ + (size_t)(r - L) * D; float s = 0.f;
#pragma unroll
            for (int j = 0; j < 8; ++j) { const f32x4 v = *(const f32x4*)(src + 4 * lane + 256 * j); s += v.x * v.x + v.y * v.y + v.z * v.z + v.w * v.w; }
            s = wave_sum(s); if (lane == 0) RSTD[r] = 1.0f / sqrtf(s * (1.f / D) + 1e-6f); }
    }
    for (int rep_ = 0; rep_ < 1 + (int)((REPMASK >> 0) & 1u); ++rep_) { PH_VARS
        for (size_t k = gtid; k < 8192; k += GT) { const float t1 = (float)k * (1.f / 4096.f), t2 = (float)k * (1.f / 8192.f);
            TW1[k] = (f32x2){cospif(t1), -sinpif(t1)}; TW2[k] = (f32x2){cospif(t2), -sinpif(t2)}; }
    }
    if (a.ws == nullptr) grid.sync();
    GRID_BAR();

    for (int rep_ = 0; rep_ < 1 + (int)((REPMASK >> 1) & 1u); ++rep_) { PH_VARS
      if (wave >= 4) {
        const size_t gtid4 = (size_t)bid * 256 + (tid - 256), GT4 = (size_t)G * 256;
        for (size_t i = gtid4; i < (size_t)2 * 64 * D / 8; i += GT4) { const size_t e = i * 8; const int blk = (int)(e / (64 * D)); const size_t off = e % (64 * D);
            *(u32x4*)(WCAT + (size_t)(blk == 0 ? 6336 : 6592) * D + off) = (u32x4){0u, 0u, 0u, 0u}; }
        const float* w2 = IN(18); const float* a2 = IN(21); const float* g2 = IN(23);
#pragma unroll 4
        for (size_t i = gtid4; i < (size_t)10240 * 256; i += GT4) { const int n = (int)(i % 10240), k = (int)(i / 10240); float v = 0.f;
            if (n < 8192) { const int nn = n & 4095, d = nn >> 11, c = nn & 2047, kk = k - 96 * d; const float* src = n < 4096 ? w2 : a2;
                if (kk >= 0 && kk < 96) v = src[((size_t)d * 96 + kk) * D + c]; }
            else v = g2[(size_t)k * D + (n - 8192)];
            W2CAT[(size_t)n * 256 + k] = f2bf(v); }
        LAS float* scr = smf + (wave - 4) * (64 * 33);
        constexpr int I_SQ = 32 * 64, I_L = 32 * 3, I_G1 = 32 * 8, I_F = 32 * 176, I_F2 = 88 * 64;
        constexpr int NIT = 3 * I_SQ + 4 * I_L + I_G1; (void)I_F; (void)I_F2;
        for (int it = bid * 4 + (wave - 4); it < NIT; it += G * 4) {
            int r = it;
            if (r < I_SQ) { transpose_mat(IN(12), D, WCAT, D, 0, 0, r, scr, lane); continue; } r -= I_SQ;
            if (r < I_SQ) { transpose_mat(IN(13), D, WCAT, D, 0, 2048, r, scr, lane); continue; } r -= I_SQ;
            if (r < I_SQ) { transpose_mat(IN(14), D, WCAT, D, 0, 4096, r, scr, lane); continue; } r -= I_SQ;
            if (r < I_L) { transpose_mat(IN(17), 96, WCAT, D, 0, 6144, r, scr, lane); continue; } r -= I_L;
            if (r < I_L) { transpose_mat(IN(17) + (size_t)D * 96, 96, WCAT, D, 0, 6240, r, scr, lane); continue; } r -= I_L;
            if (r < I_L) { transpose_mat(IN(20), 96, WCAT, D, 0, 6400, r, scr, lane); continue; } r -= I_L;
            if (r < I_L) { transpose_mat(IN(20) + (size_t)D * 96, 96, WCAT, D, 0, 6496, r, scr, lane); continue; } r -= I_L;
            transpose_mat(IN(22), 256, WCAT, D, 0, 6656, r, scr, lane);
        }
      } else
      for (int hh = 0; hh < 2; ++hh) {
        const int c0 = tid * 4 + 1024 * hh; const float* g1 = IN(6); const float* mu = IN(11); const float* xin_ = IN(0); const float* cin_ = IN(2);
        const f32x4 gv = *(const f32x4*)(g1 + c0);
        const f32x4 scL = *(const f32x4*)(MOD + 2048 + c0), shL = *(const f32x4*)(MOD + c0);
        const f32x4 scC = *(const f32x4*)(MOD + 12288 + 2048 + c0), shC = *(const f32x4*)(MOD + 12288 + c0);
        const f32x4 AL = gv * (scL + 1.f), AC = gv * (scC + 1.f);
        f32x4 muv[6];
#pragma unroll
        for (int m = 0; m < 6; ++m) muv[m] = *(const f32x4*)(mu + m * D + c0);
        const int q = c0 >> 9;
        for (int t0 = bid; t0 < MT; t0 += 3 * G) {
            f32x4 xv[3], xn[3]; float rs[3], rn[3]; bool vld[3], latv[3]; int tt[3];
#pragma unroll
            for (int j = 0; j < 3; ++j) {
                int t = t0 + j * G; if (t >= MT) t = t0; tt[j] = t;
                const bool lat = t < L; int tn = t; bool valid;
                if (lat) { const int col = t & 63, row = t >> 6;
                    if (q == 0) { valid = col > 0; tn = t - 1; } else if (q == 1) { valid = col < 63; tn = t + 1; } else if (q == 2) { valid = row > 0; tn = t - 64; } else { valid = row < 127; tn = t + 64; } }
                else { const int i = t - L; if (q < 2) { valid = i > 0; tn = t - 1; } else { valid = i < CT - 1; tn = t + 1; } }
                if (!valid) tn = t;
                const float* xp = lat ? xin_ + (size_t)t * D : cin_ + (size_t)(t - L) * D;
                const float* xq = lat ? xin_ + (size_t)tn * D : cin_ + (size_t)(tn - L) * D;
                xv[j] = *(const f32x4*)(xp + c0); xn[j] = *(const f32x4*)(xq + c0); rs[j] = RSTD[t]; rn[j] = RSTD[tn]; vld[j] = valid; latv[j] = lat;
            }
#pragma unroll
            for (int j = 0; j < 3; ++j) {
                if (j > 0 && t0 + j * G >= MT) continue;
                const f32x4 Am = latv[j] ? AL : AC, Sh = latv[j] ? shL : shC;
                const f32x4 h = xv[j] * rs[j] * Am + Sh;
                f32x4 hs = xn[j] * rn[j] * Am + Sh; if (!vld[j]) hs = (f32x4){0.f, 0.f, 0.f, 0.f};
                const f32x4 xx = hs - h;
#pragma unroll
                for (int m = 0; m < 6; ++m) { const f32x4 v = h + xx * muv[m]; u32x2 o; o.x = pk2(v.x, v.y); o.y = pk2(v.z, v.w);
                    *(u32x2*)(XM + (size_t)m * ((size_t)MT * D) + (size_t)tt[j] * D + c0) = o; }
            }
        }
      }
    }
    GRID_BAR();

    for (int rep_ = 0; rep_ < 1 + (int)((REPMASK >> 2) & 1u); ++rep_) { PH_VARS
        pg8::Gemm g{XM, WCAT, MT, 6912, D, 1, XM_STRIDE}; pg8::StaticOrder S; S.init(MT, 6912, G, bid);
        pg8::EpiP2 E{RB, KF, VB, L1B};
        pg8::gemm_phase<pg8::EpiP2>(lds, g, S, E);
        { const int ntile2 = (MT / 256) * (6912 / 256), nb2 = ntile2 - (ntile2 / G) * G;
          int b2 = bid, G2 = G; bool act2 = true;
          if (nb2 > 0 && nb2 < G) { b2 = bid - nb2; G2 = G - nb2; act2 = bid >= nb2; }
          if (act2) {
        const float* fw0 = IN(33); const float* fb0 = IN(34); const float* fw1 = IN(35); const float* fb1 = IN(36);
        const float* fw2 = IN(37); const float* fb2 = IN(38); const float* freq = IN(39);
        LAS float* zb = smf; LAS float* h1 = smf + 8 * 36; LAS float* h2 = h1 + 512;
        LAS float* lw0 = smf + 2048; LAS float* lw1 = lw0 + 33 * 64; LAS float* lw2 = lw1 + 64 * 64;
        for (int i = tid; i < 33 * 64; i += NTHR) lw0[i] = fw0[i];
        for (int i = tid; i < 64 * 64; i += NTHR) { lw1[i] = fw1[i]; lw2[i] = fw2[i]; }
        __syncthreads();
        const int tl = tid >> 6, j = tid & 63; const float fq_ = freq[j];
        for (int it = b2; it < 1024; it += G2) {
            const int t = it * 8 + tl;
            if (j < 33) { float z;
                if (j == 0) z = (float)t * (1.f / 8191.f);
                else { const int band = (j - 1) & 15; const float f = 1e-4f + (float)band * ((15.f - 1e-4f) / 15.f); const float w = (6.283185307179586f * (float)t) / 8192.f;
                    const float wp = (2.f * (float)t) / 8192.f;
                    z = j <= 16 ? cospif(f * wp) : -sinpif(f * wp); (void)w; }
                zb[tl * 36 + j] = z; }
            __syncthreads();
            float acc = fb0[j];
#pragma unroll 4
            for (int i = 0; i < 33; ++i) acc += zb[tl * 36 + i] * lw0[i * 64 + j];
            h1[tl * 64 + j] = sinpif(fq_ * acc * 0.3183098861837907f);
            __syncthreads();
            acc = fb1[j];
#pragma unroll 8
            for (int i = 0; i < 64; ++i) acc += h1[tl * 64 + i] * lw1[i * 64 + j];
            h2[tl * 64 + j] = sinpif(fq_ * acc * 0.3183098861837907f);
            __syncthreads();
            acc = fb2[j];
#pragma unroll 8
            for (int i = 0; i < 64; ++i) acc += h2[tl * 64 + i] * lw2[i * 64 + j];
            const float h3 = sinpif(fq_ * acc * 0.3183098861837907f);
            const bf16_t hi = f2bf(h3), lo = f2bf(h3 - bf2f(hi));
            bf16_t* o = HIDP + (size_t)t * 256 + j; o[0] = hi; o[64] = hi; o[128] = lo; o[192] = 0;
            __syncthreads();
        }
        const float* wout = IN(40);
        for (size_t i = (size_t)b2 * NTHR + tid; i < (size_t)4096 * 64; i += (size_t)G2 * NTHR) { const int c = (int)(i >> 6), jj = (int)(i & 63); const float w = wout[(size_t)jj * 4096 + c];
            const bf16_t hi = f2bf(w), lo = f2bf(w - bf2f(hi)); bf16_t* o = WOUTP + (size_t)c * 256 + jj; o[0] = hi; o[64] = lo; o[128] = hi; o[192] = 0; }
          } }
    }
    GRID_BAR();
    for (int rep_ = 0; rep_ < 1 + (int)((REPMASK >> 3) & 1u); ++rep_) { PH_VARS
        pg8::Gemm g{L1B, W2CAT, MT, 10240, 256, 2, L1_STRIDE}; pg8::StaticOrder S; S.init(MT, 10240, G, bid);
        pg8::EpiP3 E{DEC, ASB, GB, IN(16), IN(19)};
        pg8::gemm_phase<pg8::EpiP3>(lds, g, S, E);
    }
    GRID_BAR();

    for (int rep_ = 0; rep_ < 1 + (int)((REPMASK >> 4) & 1u); ++rep_) { PH_VARS
        constexpr int TC = 32, BUFSZ = 5 * TC * 64 + TC * 16;
        LAS float* ybuf = smf + 2 * BUFSZ;
        const float* k_k = IN(24); const float* k_a = IN(25);
        for (int job = bid; job < 256; job += G) {
            const int dir = job >> 7, head = (job & 127) >> 2, rg = job & 3;
            const int si = tid >> 4, j4 = (tid & 15) * 4, chb = head * 64 + j4;
            const f32x4 kkw = *(const f32x4*)(k_k + chb), kaw = *(const f32x4*)(k_a + chb);
            const int rl = tid >> 4, cgp = tid & 15;
            f32x2 s01 = (f32x2){0.f, 0.f}, s23 = (f32x2){0.f, 0.f};
            bf16_t* Yd = dir == 0 ? Y0 : Y1;
            f32x4 pk_, pdec, qk_, qdec; u32x2 pa, pr, pv, qa, qr, qv;
            const int sA = (tid & 255) >> 4, sB = sA + 16;
#define SCAN_ROW(n) ((n) < CT ? (dir == 0 ? L + (n) : L + CT - 1 - (n)) : (dir == 0 ? (n) - CT : L - 1 - ((n) - CT)))
#define SCAN_LOAD1(c, SI, K_, DEC_, A_, R_, V_) do { const int _row = SCAN_ROW((c) * TC + (SI)); \
                K_ = *(const f32x4*)(KF + (size_t)_row * D + chb); DEC_ = *(const f32x4*)(DEC + (size_t)_row * 4096 + dir * D + chb); \
                A_ = *(const u32x2*)(ASB + (size_t)_row * 4096 + dir * D + chb); R_ = *(const u32x2*)(RB + (size_t)_row * D + chb); \
                if ((tid & 15) < 4) V_ = *(const u32x2*)(VB + (size_t)_row * D + head * 64 + rg * 16 + j4); } while (0)
#define SCAN_STAGE1(b, SI, K_, DEC_, A_, R_, V_) do { LAS float* _B = smf + (b) * BUFSZ; \
                f32x4 _kk = K_ * kkw; float _ss = _kk.x * _kk.x + _kk.y * _kk.y + _kk.z * _kk.z + _kk.w * _kk.w; _ss = red16(_ss); \
                const float _inv = 1.f / fmaxf(sqrtf(_ss), 1e-12f); _kk = _kk * _inv; \
                const f32x4 _a = (f32x4){bflo(A_.x), bfhi(A_.x), bflo(A_.y), bfhi(A_.y)}; \
                const f32x4 _kd = K_ * ((_a - 1.f) * kaw + 1.f); const f32x4 _bb = _kk * _a; \
                const f32x4 _r = (f32x4){bflo(R_.x), bfhi(R_.x), bflo(R_.y), bfhi(R_.y)}; \
                *(LAS f32x4*)(_B + (SI) * 64 + j4) = _kk; *(LAS f32x4*)(_B + 2048 + (SI) * 64 + j4) = DEC_; *(LAS f32x4*)(_B + 4096 + (SI) * 64 + j4) = _bb; \
                *(LAS f32x4*)(_B + 6144 + (SI) * 64 + j4) = _kd; *(LAS f32x4*)(_B + 8192 + (SI) * 64 + j4) = _r; \
                if ((tid & 15) < 4) *(LAS f32x4*)(_B + 10240 + (SI) * 16 + j4) = (f32x4){bflo(V_.x), bfhi(V_.x), bflo(V_.y), bfhi(V_.y)}; } while (0)
#define SCAN_FLUSH(cb) do { if ((cb) * TC >= CT) { _Pragma("unroll") for (int _h = 0; _h < 2; ++_h) { const int _o = (tid & 255) + 256 * _h, _i = _o >> 4, _r16 = _o & 15; const int _row = SCAN_ROW((cb) * TC + _i); \
                const LAS f32x4* _yp = (const LAS f32x4*)(ybuf + ((cb) & 1) * 4096 + _o * 8); const f32x4 _qs = _yp[0] + _yp[1]; \
                Yd[(size_t)_row * D + head * 64 + rg * 16 + _r16] = f2bf((_qs.x + _qs.y) + (_qs.z + _qs.w)); } } } while (0)
#define SCAN_LOAD(c) do { SCAN_LOAD1(c, sA, pk_, pdec, pa, pr, pv); SCAN_LOAD1(c, sB, qk_, qdec, qa, qr, qv); } while (0)
#define SCAN_STAGE(b) do { SCAN_STAGE1(b, sA, pk_, pdec, pa, pr, pv); SCAN_STAGE1(b, sB, qk_, qdec, qa, qr, qv); } while (0)
            if (tid >= 256) { SCAN_LOAD(0); SCAN_STAGE(0); }
            __syncthreads();
            constexpr int NCH = MT / TC;
            constexpr int SC_ISQ = 32 * 64, SC_IIN = 32 * 192, SC_IF = 32 * 176, SC_IF2 = 88 * 64, SC_NIT = 2 * (2 * SC_IF + SC_IF2) + SC_IIN + 2 * SC_ISQ;
            float tvs[32];
#pragma unroll
            for (int i = 0; i < 32; ++i) tvs[i] = 0.f;
            for (int c = 0; c < NCH; ++c) {
                if (tid >= 256) {
                    if (c > 0) SCAN_FLUSH(c - 1);
                    if (c + 1 < NCH) SCAN_LOAD(c + 1);
                    LAS float* scr = smf + 2 * BUFSZ + 8192 + (wave - 4) * (64 * 33);
#pragma unroll
                    for (int ph = 0; ph < 2; ++ph) {
                        int r = ((c - 1 + ph) * G + bid) * 4 + (wave - 4);
                        if (r >= 0 && r < SC_NIT && (ph == 1 || c > 0)) {
                            const float* Wsrc; bf16_t* Wdst; int Nn, ldt, rowmode = 0, row_off = 0;
                            if (r < SC_IF) { Wsrc = IN(8); Wdst = WF13_0; Nn = FF; ldt = D; rowmode = 1; }
                            else if ((r -= SC_IF) < SC_IF) { Wsrc = IN(9); Wdst = WF13_0; Nn = FF; ldt = D; rowmode = 1; row_off = 128; }
                            else if ((r -= SC_IF) < SC_IF2) { Wsrc = IN(10); Wdst = WF2_0; Nn = D; ldt = FF; }
                            else if ((r -= SC_IF2) < SC_IIN) { Wsrc = IN(29); Wdst = WHYIN; Nn = 6144; ldt = D; }
                            else if ((r -= SC_IIN) < SC_ISQ) { Wsrc = IN(42); Wdst = WHYOUT; Nn = D; ldt = D; }
                            else if ((r -= SC_ISQ) < SC_IF) { Wsrc = IN(8) + (size_t)D * FF; Wdst = WF13_1; Nn = FF; ldt = D; rowmode = 1; }
                            else if ((r -= SC_IF) < SC_IF) { Wsrc = IN(9) + (size_t)D * FF; Wdst = WF13_1; Nn = FF; ldt = D; rowmode = 1; row_off = 128; }
                            else if ((r -= SC_IF) < SC_IF2) { Wsrc = IN(10) + (size_t)FF * D; Wdst = WF2_1; Nn = D; ldt = FF; }
                            else { r -= SC_IF2; Wsrc = IN(15); Wdst = WO; Nn = D; ldt = D; }
                            const int nblk = Nn / 32, kb = r / nblk, nbq = r % nblk, k0 = 64 * kb, n0 = 32 * nbq;
                            const int drow0 = rowmode == 0 ? row_off + n0 : (n0 >> 7) * 256 + (n0 & 127) + row_off;
                            if (ph == 0) transpose_finish(Wdst, ldt, drow0, k0, scr, lane, tvs); else transpose_load(Wsrc, Nn, k0, n0, lane, tvs);
                        }
                    }
                    if (c + 1 < NCH) SCAN_STAGE((c + 1) & 1);
                } else {
                    const LAS float* B = smf + (c & 1) * BUFSZ + 4 * cgp; const LAS float* Bv = smf + (c & 1) * BUFSZ + 10240 + rl;
                    LAS float* yb = ybuf + (c & 1) * 4096 + rl * 8 + (cgp & 7);
                    f32x4 kk = *(const LAS f32x4*)(B), w = *(const LAS f32x4*)(B + 2048), bb = *(const LAS f32x4*)(B + 4096), kd = *(const LAS f32x4*)(B + 6144), rr = *(const LAS f32x4*)(B + 8192);
                    float vt = Bv[0];
#pragma unroll 4
                    for (int i = 0; i < TC; ++i) {
                        const int in = (i + 1 < TC) ? i + 1 : i;
                        const f32x4 kk_n = *(const LAS f32x4*)(B + in * 64), w_n = *(const LAS f32x4*)(B + 2048 + in * 64), bb_n = *(const LAS f32x4*)(B + 4096 + in * 64);
                        const f32x4 kd_n = *(const LAS f32x4*)(B + 6144 + in * 64), rr_n = *(const LAS f32x4*)(B + 8192 + in * 64); const float vt_n = Bv[in * 16];
                        f32x2 pp = s01 * (f32x2){kk.x, kk.y}; pp = s23 * (f32x2){kk.z, kk.w} + pp;
                        float p = pp.x + pp.y; p = red16(p); const float sa = -p;
                        const f32x2 vk01 = (f32x2){kd.x, kd.y} * vt, vk23 = (f32x2){kd.z, kd.w} * vt;
                        s01 = s01 * (f32x2){w.x, w.y} + ((f32x2){bb.x, bb.y} * sa + vk01);
                        s23 = s23 * (f32x2){w.z, w.w} + ((f32x2){bb.z, bb.w} * sa + vk23);
                        f32x2 yy = s01 * (f32x2){rr.x, rr.y}; yy = s23 * (f32x2){rr.z, rr.w} + yy;
                        { float yp = yy.x + yy.y; yp += dpp<0x128>(yp); yb[i * 128] = yp; }
                        kk = kk_n; w = w_n; bb = bb_n; kd = kd_n; rr = rr_n; vt = vt_n;
                    }
                }
                __syncthreads();
            }
            if (tid >= 256) SCAN_FLUSH(NCH - 1);
            __syncthreads();
#undef SCAN_FLUSH
#undef SCAN_ROW
#undef SCAN_LOAD
#undef SCAN_STAGE
#undef SCAN_LOAD1
#undef SCAN_STAGE1
        }
    }
    GRID_BAR();

    for (int rep_ = 0; rep_ < 1 + (int)((REPMASK >> 5) & 1u); ++rep_) { PH_VARS
        const float* k_a = IN(25); const float* r_k = IN(26); const float* lw = IN(27); const float* lb = IN(28);
        for (int task = gw; task < L * 8; task += NGW) {
            const int t = task >> 3, c = (task & 7) * 256 + lane * 4; const size_t o = (size_t)t * D + c;
            const u32x2 y0b = *(const u32x2*)(Y0 + o), y1b = *(const u32x2*)(Y1 + o);
            const f32x4 y = (f32x4){bflo(y0b.x), bfhi(y0b.x), bflo(y0b.y), bfhi(y0b.y)} + (f32x4){bflo(y1b.x), bfhi(y1b.x), bflo(y1b.y), bfhi(y1b.y)};
            const float mean = red16(y.x + y.y + y.z + y.w) * (1.f / 64.f); const f32x4 dl = y - mean;
            const float var = red16(dl.x * dl.x + dl.y * dl.y + dl.z * dl.z + dl.w * dl.w) * (1.f / 64.f);
            const f32x4 yn = dl * (1.0f / sqrtf(var + 64e-5f)) * *(const f32x4*)(lw + c) + *(const f32x4*)(lb + c);
            const u32x2 rb = *(const u32x2*)(RB + o), vb = *(const u32x2*)(VB + o), gb = *(const u32x2*)(GB + o);
            const u32x2 a0b = *(const u32x2*)(ASB + (size_t)t * 4096 + c), a1b = *(const u32x2*)(ASB + (size_t)t * 4096 + D + c);
            const f32x4 k = *(const f32x4*)(KF + o), ka = *(const f32x4*)(k_a + c), rk = *(const f32x4*)(r_k + c);
            const f32x4 r = (f32x4){bflo(rb.x), bfhi(rb.x), bflo(rb.y), bfhi(rb.y)}, v = (f32x4){bflo(vb.x), bfhi(vb.x), bflo(vb.y), bfhi(vb.y)};
            const f32x4 gg = (f32x4){bflo(gb.x), bfhi(gb.x), bflo(gb.y), bfhi(gb.y)};
            const f32x4 a0 = (f32x4){bflo(a0b.x), bfhi(a0b.x), bflo(a0b.y), bfhi(a0b.y)}, a1 = (f32x4){bflo(a1b.x), bfhi(a1b.x), bflo(a1b.y), bfhi(a1b.y)};
            const f32x4 kb = k * ((a0 + a1 - 2.f) * ka + 2.f); const f32x4 pr = r * kb * rk;
            const float bs = red16(pr.x + pr.y + pr.z + pr.w);
            const f32x4 ov = (yn + v * bs) * gg; u32x2 w; w.x = pk2(ov.x, ov.y); w.y = pk2(ov.z, ov.w);
            *(u32x2*)(AO + o) = w;
        }
    }
    GRID_BAR();
    for (int rep_ = 0; rep_ < 1 + (int)((REPMASK >> 6) & 1u); ++rep_) { PH_VARS
        pg8::Gemm g{AO, WO, L, D, D, 0, 0}; pg8::StaticOrder S; S.init(L, D, G, bid);
        pg8::EpiRes E{IN(0), XL, MOD + 2 * 2048, nullptr};
        pg8::gemm_phase<pg8::EpiRes>(lds, g, S, E);
    }
    GRID_BAR();

#define NORM_ROWS(SRC, GAMMA, SC, SH, DST) do { const float* _srcb = (SRC); const float* _gm = (GAMMA); const float* _sc = (SC); const float* _sh = (SH); bf16_t* _dst = (DST); \
        for (int r = gw; r < L; r += 4 * NGW) { f32x4 va[4][8]; float sq[4]; \
            _Pragma("unroll") for (int k = 0; k < 4; ++k) { const int rk = (r + k * NGW < L) ? r + k * NGW : r; const float* srck = _srcb + (size_t)rk * D; \
                _Pragma("unroll") for (int j = 0; j < 8; ++j) va[k][j] = *(const f32x4*)(srck + 4 * lane + 256 * j); } \
            _Pragma("unroll") for (int k = 0; k < 4; ++k) { float s_ = 0.f; \
                _Pragma("unroll") for (int j = 0; j < 8; ++j) s_ += va[k][j].x * va[k][j].x + va[k][j].y * va[k][j].y + va[k][j].z * va[k][j].z + va[k][j].w * va[k][j].w; \
                sq[k] = s_; } \
            _Pragma("unroll") for (int o_ = 1; o_ < 64; o_ <<= 1) { _Pragma("unroll") for (int k = 0; k < 4; ++k) sq[k] += __shfl_xor(sq[k], o_); } \
            _Pragma("unroll") for (int k = 0; k < 4; ++k) sq[k] = 1.0f / sqrtf(sq[k] * (1.f / D) + 1e-6f); \
            _Pragma("unroll") for (int j = 0; j < 8; ++j) { const int c = 4 * lane + 256 * j; const f32x4 gv = *(const f32x4*)(_gm + c), sc = *(const f32x4*)(_sc + c), sh = *(const f32x4*)(_sh + c); \
                const f32x4 gs = gv * (sc + 1.f); \
                _Pragma("unroll") for (int k = 0; k < 4; ++k) { if (r + k * NGW < L) { const f32x4 o = va[k][j] * sq[k] * gs + sh; u32x2 w; w.x = pk2(o.x, o.y); w.y = pk2(o.z, o.w); \
                    *(u32x2*)(_dst + (size_t)(r + k * NGW) * D + c) = w; } } } } } while (0)

    for (int rep_ = 0; rep_ < 1 + (int)((REPMASK >> 7) & 1u); ++rep_) { PH_VARS
        NORM_ROWS(XL, IN(7), MOD + 4 * 2048, MOD + 3 * 2048, A2);
    }
    GRID_BAR();
    for (int rep_ = 0; rep_ < 1 + (int)((REPMASK >> 8) & 1u); ++rep_) { PH_VARS
        pg8::Gemm g{A2, WF13_0, L, 2 * FF, D, 0, 0}; pg8::StaticOrder S; S.init(L, 2 * FF, G, bid);
        pg8::EpiSwi E{HID};
        pg8::gemm_phase<pg8::EpiSwi>(lds, g, S, E);
        { const int ntile = (L / 256) * (2 * FF / 256), nbig = ntile - (ntile / G) * G;
          int Gf = G, cf = bid; bool act = true;
          if (nbig > 0 && nbig < G) { Gf = G - nbig; cf = bid - nbig; act = bid >= nbig; }
          if (act) { pg8::Gemm gf{WOUTP, HIDP, 4096, L, 256, 0, 0}; pg8::StaticOrder Sf; Sf.init(4096, L, Gf, cf);
              pg8::EpiFilt Ef{FILT};
              pg8::gemm_phase<pg8::EpiFilt>(lds, gf, Sf, Ef); } }
    }
    GRID_BAR();
    for (int rep_ = 0; rep_ < 1 + (int)((REPMASK >> 9) & 1u); ++rep_) { PH_VARS
        pg8::Gemm g{HID, WF2_0, L, D, FF, 0, 0}; pg8::StaticOrder S; S.init(L, D, G, bid);
        pg8::EpiRes E{XL, XL, MOD + 5 * 2048, nullptr};
        pg8::gemm_phase<pg8::EpiRes>(lds, g, S, E);
    }
    GRID_BAR();

    for (int rep_ = 0; rep_ < 1 + (int)((REPMASK >> 10) & 1u); ++rep_) { PH_VARS NORM_ROWS(XL, IN(6) + D, MOD + 2 * 12288 + 2048, MOD + 2 * 12288, A2); }
    GRID_BAR();
    for (int rep_ = 0; rep_ < 1 + (int)((REPMASK >> 11) & 1u); ++rep_) { PH_VARS
        { pg8::Gemm g{A2, WHYIN, L, 3 * D, D, 0, 0}; pg8::StaticOrder S; S.init(L, 3 * D, G, bid);
          pg8::EpiBf16B E{UPRE, 3 * D, IN(30)};
          pg8::gemm_phase<pg8::EpiBf16B>(lds, g, S, E); }
    }
    GRID_BAR();
    for (int rep_ = 0; rep_ < 1 + (int)((REPMASK >> 12) & 1u); ++rep_) { PH_VARS
        const float* sw = IN(31); const float* sb = IN(32);
        LAS float* sx0 = smf; LAS float* svv = smf + 64 * 65;
        for (int tile = bid; tile < 128 * 32; tile += G) {
            const int tt = tile >> 5, ctile = tile & 31, t0 = tt * 64, cbase = ctile * 64;
            const int tl = tid >> 4, c4 = (tid & 15) * 4;
#pragma unroll
            for (int half = 0; half < 2; ++half) {
                const int t = t0 + half * 32 + tl; f32x4 u3[3];
#pragma unroll
                for (int gI = 0; gI < 3; ++gI) { const int col = gI * D + cbase + c4;
                    const f32x4 wA = *(const f32x4*)(sw + col), wB = *(const f32x4*)(sw + 3 * D + col), wC = *(const f32x4*)(sw + 6 * D + col), bb = *(const f32x4*)(sb + col);
#define LDU4(tt_) ({ const u32x2 _u = *(const u32x2*)(UPRE + (size_t)(tt_) * (3 * D) + col); (f32x4){bflo(_u.x), bfhi(_u.x), bflo(_u.y), bfhi(_u.y)}; })
                    f32x4 acc = bb + LDU4(t) * wB;
                    if (t > 0) acc += LDU4(t - 1) * wA;
                    if (t < L - 1) acc += LDU4(t + 1) * wC;
#undef LDU4
                    u3[gI] = acc; }
                const f32x4 vv = u3[2] * u3[1];
#pragma unroll
                for (int j = 0; j < 4; ++j) { sx0[(c4 + j) * 65 + half * 32 + tl] = u3[0][j]; svv[(c4 + j) * 65 + half * 32 + tl] = vv[j]; }
            }
            __syncthreads();
            { const int c = tid >> 3, t8 = (tid & 7) * 8; f32x4 o0, o1, p0, p1;
#pragma unroll
              for (int j = 0; j < 4; ++j) { o0[j] = sx0[c * 65 + t8 + j]; o1[j] = sx0[c * 65 + t8 + 4 + j]; p0[j] = svv[c * 65 + t8 + j]; p1[j] = svv[c * 65 + t8 + 4 + j]; }
              const size_t o = (size_t)(cbase + c) * L + t0 + t8;
              *(f32x4*)(X0T + o) = o0; *(f32x4*)(X0T + o + 4) = o1; *(f32x4*)(VVT + o) = p0; *(f32x4*)(VVT + o + 4) = p1; }
            __syncthreads();
        }
    }
    GRID_BAR();
    for (int rep_ = 0; rep_ < 1 + (int)((REPMASK >> 13) & 1u); ++rep_) { PH_VARS
        constexpr int M = 8192;
        LAS f32x2* Fz = (LAS f32x2*)lds_raw; LAS f32x2* Sz = Fz + M; LAS f32x2* TWL = Sz + M;
        const float* hbias = IN(41);
        for (int e = tid; e < 2048; e += NTHR) TWL[e] = TW1[e];
        __syncthreads();
#define CMUL(a, b) ((a) * (b).xx + (a).yx * (f32x2){-(b).y, (b).y})
#define CMULC(a, b) ((a) * (b).xx + (a).yx * (f32x2){(b).y, -(b).y})
        f32x2 nf[8], nb[8], ns[8];
#define FFT_PREFETCH(chn) do { const float* fwd_ = FILT + (size_t)(chn) * L; const float* bwd_ = FILT + (size_t)(D + (chn)) * L; const float* sig_ = VVT + (size_t)(chn) * L; const float* x0_ = X0T + (size_t)(chn) * L; \
            _Pragma("unroll") for (int u = 0; u < 8; ++u) { const int m = tid + 512 * u, idx = 8192 - 2 * m; \
                nf[u] = *(const f32x2*)(fwd_ + 2 * m); ns[u] = *(const f32x2*)(sig_ + 2 * m); (void)x0_; \
                nb[u].x = (idx == 8192) ? 0.f : bwd_[idx == 8192 ? 0 : idx]; nb[u].y = bwd_[idx - 1]; } } while (0)
        for (int ch = bid; ch < D; ch += G) {
            FFT_PREFETCH(ch);
#pragma unroll
            for (int u = 0; u < 8; ++u) { const int m = tid + 512 * u; Fz[m] = nf[u]; Fz[4096 + m] = nb[u]; Sz[m] = ns[u]; Sz[4096 + m] = (f32x2){0.f, 0.f}; }
            __syncthreads();
#pragma nounroll
            for (int R = 1; R <= 1024; R <<= 2) {
                f32x2 xf[4][4], xs[4][4];
#pragma unroll
                for (int u = 0; u < 4; ++u)
#pragma unroll
                    for (int q = 0; q < 4; ++q) { xf[u][q] = Fz[tid + 512 * u + 2048 * q]; xs[u][q] = Sz[tid + 512 * u + 2048 * q]; }
                __syncthreads();
#pragma unroll
                for (int u = 0; u < 4; ++u) { const int i = tid + 512 * u; const f32x2 w1 = TWL[i & ~(R - 1)]; const f32x2 w2 = CMUL(w1, w1); const f32x2 w3 = CMUL(w2, w1);
#define FWD_BF(XX, DST) do { const f32x2 t0 = XX[u][0] + XX[u][2], t1 = XX[u][0] - XX[u][2], t2 = XX[u][1] + XX[u][3], t3 = XX[u][1] - XX[u][3]; \
                        const f32x2 rot = t3.yx * (f32x2){1.f, -1.f}; const f32x2 y0 = t0 + t2, y2r = t0 - t2, y1r = t1 + rot, y3r = t1 - rot; \
                        const f32x2 y1 = CMUL(y1r, w1), y2 = CMUL(y2r, w2), y3 = CMUL(y3r, w3); \
                        *(LAS f32x4*)(DST + 4 * i) = (f32x4){y0.x, y0.y, y1.x, y1.y}; *(LAS f32x4*)(DST + 4 * i + 2) = (f32x4){y2.x, y2.y, y3.x, y3.y}; } while (0)
                    FWD_BF(xf, Fz); FWD_BF(xs, Sz);
#undef FWD_BF
                }
                __syncthreads();
            }
            {
                f32x2 xf[8][2], xs[8][2];
#pragma unroll
                for (int u = 0; u < 8; ++u) { xf[u][0] = Fz[tid + 512 * u]; xf[u][1] = Fz[tid + 512 * u + 4096]; xs[u][0] = Sz[tid + 512 * u]; xs[u][1] = Sz[tid + 512 * u + 4096]; }
                __syncthreads();
#pragma unroll
                for (int u = 0; u < 8; ++u) { const int i = tid + 512 * u; const f32x2 f0 = xf[u][0] + xf[u][1], f1 = xf[u][0] - xf[u][1], s0 = xs[u][0] + xs[u][1], s1 = xs[u][0] - xs[u][1];
                    *(LAS f32x4*)(Fz + 2 * i) = (f32x4){f0.x, f0.y, f1.x, f1.y}; *(LAS f32x4*)(Sz + 2 * i) = (f32x4){s0.x, s0.y, s1.x, s1.y}; }
                __syncthreads();
            }
            int tidS = tid; asm volatile("" : "+v"(tidS));
#pragma unroll 2
            for (int u = 0; u < 16; ++u) { const int pk = tidS + 512 * u;
                const int k = ((pk >> 11) & 3) | (((pk >> 9) & 3) << 2) | (((pk >> 7) & 3) << 4) | (((pk >> 5) & 3) << 6) | (((pk >> 3) & 3) << 8) | (((pk >> 1) & 3) << 10) | ((pk & 1) << 12);
                if (k > M / 2) continue;
                if (k == 0) { const f32x2 zs0 = Sz[0], zf0 = Fz[0];
                    const float Y0_ = (zs0.x + zs0.y) * (zf0.x + zf0.y), YM = (zs0.x - zs0.y) * (zf0.x - zf0.y);
                    Sz[0] = (f32x2){0.5f * (Y0_ + YM), 0.5f * (Y0_ - YM)}; }
                else {
                    const int kp = M - k;
                    int pkp = 0; { int kk2 = kp;
#pragma unroll
                        for (int st = 0; st < 6; ++st) { pkp = pkp * 4 + (kk2 & 3); kk2 >>= 2; }
                        pkp = pkp * 2 + kk2; }
                    f32x2 wk = (f32x2){0.f, -1.f};
                    if (k < M / 2) { const f32x2 wb = TWL[k >> 1]; const f32x2 c1 = (f32x2){0.9999999264657179f, -0.00038349518757139556f}; wk = (k & 1) ? CMUL(wb, c1) : wb; }
                    const f32x2 wkp = (f32x2){-wk.x, wk.y};
                    const f32x2 Sa = Sz[pk], Sb = Sz[pkp], Fa = Fz[pk], Fb = Fz[pkp];
#define XSPEC(Za, Zb, w, out) do { const f32x2 E_ = (f32x2){0.5f * (Za.x + Zb.x), 0.5f * (Za.y - Zb.y)}; const f32x2 Dd = (f32x2){0.5f * (Za.x - Zb.x), 0.5f * (Za.y + Zb.y)}; \
                        const f32x2 O_ = (f32x2){Dd.y, -Dd.x}; out = (f32x2){E_.x + w.x * O_.x - w.y * O_.y, E_.y + w.x * O_.y + w.y * O_.x}; } while (0)
                    f32x2 Xs_k, Xs_kp, Xf_k, Xf_kp;
                    XSPEC(Sa, Sb, wk, Xs_k); XSPEC(Sb, Sa, wkp, Xs_kp); XSPEC(Fa, Fb, wk, Xf_k); XSPEC(Fb, Fa, wkp, Xf_kp);
#undef XSPEC
                    const f32x2 Yk = CMUL(Xs_k, Xf_k), Ykp = CMUL(Xs_kp, Xf_kp);
                    { const f32x2 Ye = (f32x2){0.5f * (Yk.x + Ykp.x), 0.5f * (Yk.y - Ykp.y)}; const f32x2 Dd = (f32x2){0.5f * (Yk.x - Ykp.x), 0.5f * (Yk.y + Ykp.y)};
                      const f32x2 Yo = CMULC(Dd, wk);
                      Sz[pk] = (f32x2){Ye.x - Yo.y, Ye.y + Yo.x}; }
                    { const f32x2 Ye = (f32x2){0.5f * (Ykp.x + Yk.x), 0.5f * (Ykp.y - Yk.y)}; const f32x2 Dd = (f32x2){0.5f * (Ykp.x - Yk.x), 0.5f * (Ykp.y + Yk.y)};
                      const f32x2 Yo = CMULC(Dd, wkp);
                      Sz[pkp] = (f32x2){Ye.x - Yo.y, Ye.y + Yo.x}; }
                }
            }
            __syncthreads();
            {
                f32x4 xs[8];
#pragma unroll
                for (int u = 0; u < 8; ++u) xs[u] = *(const LAS f32x4*)(Sz + 2 * (tid + 512 * u));
                __syncthreads();
#pragma unroll
                for (int u = 0; u < 8; ++u) { const int i = tid + 512 * u; Sz[i] = (f32x2){xs[u].x + xs[u].z, xs[u].y + xs[u].w}; Sz[i + 4096] = (f32x2){xs[u].x - xs[u].z, xs[u].y - xs[u].w}; }
                __syncthreads();
            }
            f32x2 cs[8], cx[8];
            { const float* sig_ = VVT + (size_t)ch * L; const float* x0_ = X0T + (size_t)ch * L;
#pragma unroll
              for (int u = 0; u < 8; ++u) { cs[u] = *(const f32x2*)(sig_ + 2 * (tid + 512 * u)); cx[u] = *(const f32x2*)(x0_ + 2 * (tid + 512 * u)); } }
#pragma nounroll
            for (int R = 1024; R >= 1; R >>= 2) {
                f32x4 xa[4], xb[4];
#pragma unroll
                for (int u = 0; u < 4; ++u) { xa[u] = *(const LAS f32x4*)(Sz + 4 * (tid + 512 * u)); xb[u] = *(const LAS f32x4*)(Sz + 4 * (tid + 512 * u) + 2); }
                __syncthreads();
#pragma unroll
                for (int u = 0; u < 4; ++u) { const int i = tid + 512 * u; const f32x2 w1 = TWL[i & ~(R - 1)]; const f32x2 w2 = CMUL(w1, w1); const f32x2 w3 = CMUL(w2, w1);
                    const f32x2 a0 = (f32x2){xa[u].x, xa[u].y}, r1 = (f32x2){xa[u].z, xa[u].w}, r2 = (f32x2){xb[u].x, xb[u].y}, r3 = (f32x2){xb[u].z, xb[u].w};
                    const f32x2 a1 = CMULC(r1, w1), a2 = CMULC(r2, w2), a3 = CMULC(r3, w3);
                    const f32x2 t0 = a0 + a2, t1 = a0 - a2, t2 = a1 + a3, t3 = a1 - a3;
                    const f32x2 rot = t3.yx * (f32x2){1.f, -1.f}; Sz[i] = t0 + t2; Sz[i + 2048] = t1 - rot; Sz[i + 4096] = t0 - t2; Sz[i + 6144] = t1 + rot; }
                __syncthreads();
            }
            { const float hb = hbias[ch]; float* zp = ZT + (size_t)ch * L;
#pragma unroll
              for (int u = 0; u < 8; ++u) { const int m = tid + 512 * u; const f32x2 z = Sz[m];
                  f32x2 o; o.x = (z.x * (1.f / M) + cs[u].x * hb) * cx[u].x; o.y = (z.y * (1.f / M) + cs[u].y * hb) * cx[u].y; *(f32x2*)(zp + 2 * m) = o; } }
            __syncthreads();
        }
#undef FFT_PREFETCH
#undef CMUL
#undef CMULC
    }
    GRID_BAR();
    for (int rep_ = 0; rep_ < 1 + (int)((REPMASK >> 14) & 1u); ++rep_) { PH_VARS
        LAS float* st = smf;
        for (int tile = bid; tile < 32 * 32; tile += G) {
            const int tt = tile >> 5, ctile = tile & 31, t0 = tt * 256, cbase = ctile * 64;
            { const int c = tid >> 3, t8 = (tid & 7) * 8; f32x4 v0[4], v1[4];
#pragma unroll
              for (int q = 0; q < 4; ++q) { const size_t o = (size_t)(cbase + c) * L + t0 + 64 * q + t8; v0[q] = *(const f32x4*)(ZT + o); v1[q] = *(const f32x4*)(ZT + o + 4); }
#pragma unroll
              for (int q = 0; q < 4; ++q)
#pragma unroll
                for (int j = 0; j < 4; ++j) { st[c * 257 + 64 * q + t8 + j] = v0[q][j]; st[c * 257 + 64 * q + t8 + 4 + j] = v1[q][j]; } }
            __syncthreads();
#pragma unroll
            for (int q = 0; q < 4; ++q) { const int tl = 64 * q + (tid >> 3), c8 = (tid & 7) * 8; u32x4 w;
              w.x = pk2(st[(c8 + 0) * 257 + tl], st[(c8 + 1) * 257 + tl]); w.y = pk2(st[(c8 + 2) * 257 + tl], st[(c8 + 3) * 257 + tl]);
              w.z = pk2(st[(c8 + 4) * 257 + tl], st[(c8 + 5) * 257 + tl]); w.w = pk2(st[(c8 + 6) * 257 + tl], st[(c8 + 7) * 257 + tl]);
              *(u32x4*)(A2 + (size_t)(t0 + tl) * D + cbase + c8) = w; }
            __syncthreads();
        }
    }
    GRID_BAR();
    for (int rep_ = 0; rep_ < 1 + (int)((REPMASK >> 15) & 1u); ++rep_) { PH_VARS
        pg8::Gemm g{A2, WHYOUT, L, D, D, 0, 0}; pg8::StaticOrder S; S.init(L, D, G, bid);
        pg8::EpiRes E{XL, XL, MOD + 2 * 12288 + 2 * 2048, IN(43)};
        pg8::gemm_phase<pg8::EpiRes>(lds, g, S, E);
    }
    GRID_BAR();
    for (int rep_ = 0; rep_ < 1 + (int)((REPMASK >> 16) & 1u); ++rep_) { PH_VARS NORM_ROWS(XL, IN(7) + D, MOD + 2 * 12288 + 4 * 2048, MOD + 2 * 12288 + 3 * 2048, A2); }
    GRID_BAR();
    for (int rep_ = 0; rep_ < 1 + (int)((REPMASK >> 17) & 1u); ++rep_) { PH_VARS
        pg8::Gemm g{A2, WF13_1, L, 2 * FF, D, 0, 0}; pg8::StaticOrder S; S.init(L, 2 * FF, G, bid);
        pg8::EpiSwi E{HID};
        pg8::gemm_phase<pg8::EpiSwi>(lds, g, S, E);
    }
    GRID_BAR();
    for (int rep_ = 0; rep_ < 1 + (int)((REPMASK >> 18) & 1u); ++rep_) { PH_VARS
        pg8::Gemm g{HID, WF2_1, L, D, FF, 0, 0}; pg8::StaticOrder S; S.init(L, D, G, bid);
        pg8::EpiRes E{XL, XL, MOD + 2 * 12288 + 5 * 2048, nullptr};
        pg8::gemm_phase<pg8::EpiRes>(lds, g, S, E);
    }
    GRID_BAR();
    for (int rep_ = 0; rep_ < 1 + (int)((REPMASK >> 19) & 1u); ++rep_) { PH_VARS
        const float* fg = IN(44);
        for (int r = gw; r < L; r += 4 * NGW) { f32x4 va[4][8]; float sq[4];
#pragma unroll
            for (int k = 0; k < 4; ++k) { const int rk = (r + k * NGW < L) ? r + k * NGW : r; const float* srck = XL + (size_t)rk * D;
#pragma unroll
                for (int j = 0; j < 8; ++j) va[k][j] = *(const f32x4*)(srck + 4 * lane + 256 * j); }
#pragma unroll
            for (int k = 0; k < 4; ++k) { float s_ = 0.f;
#pragma unroll
                for (int j = 0; j < 8; ++j) s_ += va[k][j].x * va[k][j].x + va[k][j].y * va[k][j].y + va[k][j].z * va[k][j].z + va[k][j].w * va[k][j].w;
                sq[k] = s_; }
#pragma unroll
            for (int o_ = 1; o_ < 64; o_ <<= 1) {
#pragma unroll
                for (int k = 0; k < 4; ++k) sq[k] += __shfl_xor(sq[k], o_); }
#pragma unroll
            for (int k = 0; k < 4; ++k) sq[k] = 1.0f / sqrtf(sq[k] * (1.f / D) + 1e-6f);
#pragma unroll
            for (int j = 0; j < 8; ++j) { const int c = 4 * lane + 256 * j; const f32x4 gv = *(const f32x4*)(fg + c);
#pragma unroll
                for (int k = 0; k < 4; ++k) if (r + k * NGW < L) *(f32x4*)(XL + (size_t)(r + k * NGW) * D + c) = va[k][j] * sq[k] * gv; } }
    }
}

extern "C" void kernel_launch(void* const* d_in, const int* in_sizes, int n_in, void* d_out, int out_size, void* d_ws, size_t ws_size, hipStream_t stream) {
    constexpr int LDS_BYTES = LDS_TOTAL;
    static int grid_blocks = 0;
    if (!grid_blocks) {
        int dev = 0, cus = 0, per_cu = 0;
        hipGetDevice(&dev);
        hipDeviceGetAttribute(&cus, hipDeviceAttributeMultiprocessorCount, dev);
        hipFuncSetAttribute((const void*)mega, hipFuncAttributeMaxDynamicSharedMemorySize, LDS_BYTES);
        hipOccupancyMaxActiveBlocksPerMultiprocessor(&per_cu, (const void*)mega, NTHR, LDS_BYTES);
        if (per_cu < 1) per_cu = 1;
        grid_blocks = cus * per_cu;
        if (grid_blocks > 256) grid_blocks = 256;
        if (ws_size < WS_NEED || n_in != 45) fprintf(stderr, "kernel_launch: ws %zu (need %zu), n_in %d\n", ws_size, (size_t)WS_NEED, n_in);
    }
    (void)hipMemsetAsync((char*)d_ws + WS_BAR, 0, XCD_BAR_WORDS * 4, stream);
    Args a{};
    for (int i = 0; i < 45; ++i) a.in[i] = (const float*)d_in[i];
    a.out = (float*)d_out; a.ws = (unsigned char*)d_ws;
    void* args[] = {&a};
    hipError_t e = hipLaunchCooperativeKernel((const void*)mega, dim3(grid_blocks), dim3(NTHR), args, LDS_BYTES, stream);
    if (e != hipSuccess) fprintf(stderr, "cooperative launch failed: %s (grid %d)\n", hipGetErrorString(e), grid_blocks);
}
```

```cpp
#include <hip/hip_runtime.h>
#include <hip/hip_cooperative_groups.h>
#include <cstdio>
#include <cstdint>
namespace cg = cooperative_groups;

#define LAS __attribute__((address_space(3)))
typedef unsigned short bf16_t;
typedef short bf16x8 __attribute__((ext_vector_type(8)));
typedef float f32x4 __attribute__((ext_vector_type(4)));
typedef float f32x2 __attribute__((ext_vector_type(2)));
typedef unsigned u32x4 __attribute__((ext_vector_type(4)));
typedef unsigned u32x2 __attribute__((ext_vector_type(2)));

constexpr int D = 2048, L = 8192, CT = 256, MT = L + CT, FF = 5632, NH = 32, HN = 64;
constexpr int NTHR = 512;
constexpr size_t MiB = 1u << 20;
constexpr size_t WS_MOD = 0;
constexpr size_t WS_RSTD = 256 * 1024;
constexpr size_t WS_TW1 = 320 * 1024;
constexpr size_t WS_TW2 = 384 * 1024;
constexpr size_t WS_TBL = 512 * 1024;
constexpr size_t WS_BAR = 768 * 1024;
constexpr size_t WS_HIDP = 1 * MiB;
constexpr size_t WS_WOUTP = 5 * MiB;
constexpr size_t WS_WCAT = 8 * MiB;
constexpr size_t WS_W2CAT = WS_WCAT + 27 * MiB;
constexpr size_t WS_WO = WS_W2CAT + 5 * MiB;
constexpr size_t WS_WF13_0 = WS_WO + 8 * MiB;
constexpr size_t WS_WF2_0 = WS_WF13_0 + 44 * MiB;
constexpr size_t WS_ACT = WS_WF2_0 + 22 * MiB;
constexpr size_t WS_XM = WS_ACT;
constexpr size_t XM_STRIDE = (size_t)MT * D * 2;
constexpr size_t WS_Y0 = WS_XM;
constexpr size_t WS_Y1 = WS_XM + 64 * MiB;
constexpr size_t WS_AO = WS_XM + 128 * MiB;
constexpr size_t WS_RB = WS_XM + 198 * MiB;
constexpr size_t WS_VB = WS_RB + 33 * MiB;
constexpr size_t WS_KF = WS_VB + 33 * MiB;
constexpr size_t WS_L1 = WS_KF + 66 * MiB;
constexpr size_t L1_STRIDE = (size_t)MT * 256 * 2;
constexpr size_t WS_DEC = WS_L1 + 13 * MiB;
constexpr size_t WS_ASB = WS_DEC + 132 * MiB;
constexpr size_t WS_GB = WS_ASB + 66 * MiB;
constexpr size_t WS_EARLY_END = WS_GB + 33 * MiB;
constexpr size_t WS_WHYIN = WS_XM + 160 * MiB;
constexpr size_t WS_WHYOUT = WS_WHYIN + 24 * MiB;
constexpr size_t WS_WF13_1 = WS_EARLY_END;
constexpr size_t WS_WF2_1 = WS_WF13_1 + 44 * MiB;
constexpr size_t WS_A2 = WS_ACT;
constexpr size_t WS_VVT = WS_ACT + 32 * MiB;
constexpr size_t WS_X0T = WS_VVT + 64 * MiB;
constexpr size_t WS_UPRE = WS_WHYOUT + 8 * MiB;
constexpr size_t WS_HID = WS_UPRE;
constexpr size_t WS_ZT = WS_UPRE;
constexpr size_t WS_FILT = WS_UPRE + 192 * MiB;
constexpr size_t WS_LATE_END = WS_WF2_1 + 22 * MiB;
static_assert(WS_X0T + 64 * MiB <= WS_WHYIN && WS_FILT + 128 * MiB <= WS_WF13_1, "late layout overlap");
constexpr size_t WS_NEED = WS_LATE_END > WS_EARLY_END ? WS_LATE_END : WS_EARLY_END;

#ifndef REPMASK
#define REPMASK 0u
#endif
constexpr int XB_LDS_OFF = 153600, LDS_TOTAL = 153856;
struct Args { const float* in[45]; float* out; unsigned char* ws; };

__device__ __forceinline__ unsigned pk2(float lo, float hi) { unsigned r; asm volatile("s_nop 1\n\tv_cvt_pk_bf16_f32 %0, %1, %2" : "=v"(r) : "v"(lo), "v"(hi)); return r; }
__device__ __forceinline__ bf16_t f2bf(float f) { unsigned u = __float_as_uint(f); u += 0x7FFFu + ((u >> 16) & 1u); return (bf16_t)(u >> 16); }
__device__ __forceinline__ float bf2f(unsigned b) { return __uint_as_float(b << 16); }
__device__ __forceinline__ float bflo(unsigned w) { return __uint_as_float(w << 16); }
__device__ __forceinline__ float bfhi(unsigned w) { return __uint_as_float(w & 0xFFFF0000u); }
__device__ __forceinline__ float wave_sum(float v) {
#pragma unroll
    for (int o = 1; o < 64; o <<= 1) v += __shfl_xor(v, o);
    return v;
}
template <int CTRL> __device__ __forceinline__ float dpp(float x) { return __builtin_bit_cast(float, __builtin_amdgcn_mov_dpp(__builtin_bit_cast(int, x), CTRL, 0xf, 0xf, true)); }
__device__ __forceinline__ float red16(float x) {
    x += dpp<0xB1>(x); x += dpp<0x4E>(x); x += dpp<0x141>(x); x += dpp<0x128>(x); return x;
}
__device__ __forceinline__ float sigmoidf_(float x) { return __builtin_amdgcn_rcpf(1.f + __expf(-x)); }
__device__ __forceinline__ float tanhf_(float x) { return 1.f - 2.f * __builtin_amdgcn_rcpf(1.f + __expf(2.f * x)); }
__device__ __forceinline__ const float* ldp_(const unsigned long long* tbl, int k) {
    const unsigned long long v = ((const volatile unsigned long long*)tbl)[k];
    const unsigned lo = __builtin_amdgcn_readfirstlane((unsigned)v), hi = __builtin_amdgcn_readfirstlane((unsigned)(v >> 32));
    return (const float*)(((unsigned long long)hi << 32) | lo);
}
__device__ __forceinline__ int otid() { int t = threadIdx.x; asm volatile("" : "+v"(t)); return t; }
#define LDS_WAIT() asm volatile("s_waitcnt lgkmcnt(0)" ::: "memory")

namespace pg8 {
constexpr int BM = 256, BK = 64, HALF = 128, HTB = HALF * BK * 2, STAGE_BYTES = 8 * HTB, NXCD = 8, WGM = 8;
__device__ __forceinline__ int lds_byte(int r, int c) { const int st = (r >> 4) * 2 + (c >> 5), rr = r & 15, cc = c & 31, ob = rr * 64 + cc * 2; return st * 1024 + (ob ^ (((ob >> 9) & 1) << 5)); }
__device__ __forceinline__ void stage_rc(int b, int& R, int& C) { const int st = b / 1024, sb = b % 1024, swz = sb ^ (((sb >> 9) & 1) << 5); R = (st >> 1) * 16 + swz / 64; C = (st & 1) * 32 + (swz % 64) / 2; }
__device__ __forceinline__ int perm32(int rho) { const int n = rho >> 4, i = rho & 15; return 8 * (i >> 2) + 4 * n + (i & 3); }
struct Unit { int pm, pn; };
struct Gemm { const bf16_t* A; const bf16_t* Bt; int M, N, K; int amode; size_t astride; };
__device__ __forceinline__ int aidx(int amode, int pn) { return amode == 0 ? 0 : (amode == 1 ? (pn < 8 ? 0 : (pn < 16 ? 2 : (pn < 24 ? 3 : (pn == 24 ? 1 : (pn == 25 ? 4 : 5))))) : (pn < 16 ? 0 : (pn < 32 ? 1 : 2))); }
struct StaticOrder {
    int nM, nN, nwg, G, c;
    __device__ void init(int M, int N, int G_, int c_) { nM = M / BM; nN = N / BM; nwg = nM * nN; G = G_; c = c_; }
    __device__ bool next(int i, Unit& u) const {
        const long Lx = (long)i * G + c; if (Lx >= nwg) return false;
        int wgid = (int)Lx; { const int q = nwg / NXCD, r = nwg % NXCD, xcd = wgid % NXCD, off = wgid / NXCD; wgid = (xcd < r ? xcd * (q + 1) : r * (q + 1) + (xcd - r) * q) + off; }
        const int nig = WGM * nN, gid = wgid / nig, fm = gid * WGM, gsz = (nM - fm) < WGM ? (nM - fm) : WGM;
        u.pm = fm + ((wgid % nig) % gsz); u.pn = (wgid % nig) / gsz; return true;
    }
};
__device__ __forceinline__ u32x4 pack8(f32x4 v0, f32x4 v1) { u32x4 w; w.x = pk2(v0[0], v0[1]); w.y = pk2(v0[2], v0[3]); w.z = pk2(v1[0], v1[1]); w.w = pk2(v1[2], v1[3]); return w; }

struct EpiP2 {
    static constexpr bool PERM = true;
    bf16_t* RB; float* KF; bf16_t* VB; bf16_t* L1;
    __device__ __forceinline__ void operator()(const f32x4 (&acc)[2][2][4][2], const Unit& u, int wr, int wc, int fr, int fq) const {
        const int row0 = u.pm * BM + wr * 64 + fr; const int pn = u.pn;
        if (pn >= 8 && pn < 16) {
            const int col0 = (pn - 8) * BM + wc * 32 + 8 * fq;
#pragma unroll
            for (int ai = 0; ai < 2; ++ai)
#pragma unroll
                for (int m = 0; m < 4; ++m) { float* rowp = KF + (size_t)(row0 + ai * HALF + m * 16) * D + col0;
#pragma unroll
                    for (int bj = 0; bj < 2; ++bj)
#pragma unroll
                        for (int n = 0; n < 2; ++n) *(f32x4*)(rowp + bj * HALF + 4 * n) = acc[ai][bj][m][n]; }
        } else if (pn < 24) {
            bf16_t* base = pn < 8 ? RB : VB; const int col0 = (pn & 7) * BM + wc * 32 + 8 * fq;
#pragma unroll
            for (int ai = 0; ai < 2; ++ai)
#pragma unroll
                for (int m = 0; m < 4; ++m) { bf16_t* rowp = base + (size_t)(row0 + ai * HALF + m * 16) * D + col0;
#pragma unroll
                    for (int bj = 0; bj < 2; ++bj) *(u32x4*)(rowp + bj * HALF) = pack8(acc[ai][bj][m][0], acc[ai][bj][m][1]); }
        } else {
            const int which = pn - 24; bf16_t* base = L1 + (size_t)which * ((size_t)MT * 256); const int col0 = wc * 32 + 8 * fq;
#pragma unroll
            for (int ai = 0; ai < 2; ++ai)
#pragma unroll
                for (int m = 0; m < 4; ++m) { bf16_t* rowp = base + (size_t)(row0 + ai * HALF + m * 16) * 256 + col0;
#pragma unroll
                    for (int bj = 0; bj < 2; ++bj) { f32x4 v0 = acc[ai][bj][m][0], v1 = acc[ai][bj][m][1];
                        if (which == 0) {
#pragma unroll
                            for (int j = 0; j < 4; ++j) { v0[j] = tanhf_(v0[j]); v1[j] = tanhf_(v1[j]); }
                        } else if (which == 2) {
#pragma unroll
                            for (int j = 0; j < 4; ++j) { v0[j] = sigmoidf_(v0[j]); v1[j] = sigmoidf_(v1[j]); }
                        }
                        *(u32x4*)(rowp + bj * HALF) = pack8(v0, v1); } }
        }
    }
};
struct EpiP3 {
    static constexpr bool PERM = true;
    float* DEC; bf16_t* ASB; bf16_t* GB; const float* w0; const float* a0;
    __device__ __forceinline__ void operator()(const f32x4 (&acc)[2][2][4][2], const Unit& u, int wr, int wc, int fr, int fq) const {
        const int row0 = u.pm * BM + wr * 64 + fr; const int pn = u.pn;
        if (pn < 16) {
            const int col0 = pn * BM + wc * 32 + 8 * fq;
#pragma unroll
            for (int bj = 0; bj < 2; ++bj)
#pragma unroll
                for (int n = 0; n < 2; ++n) { const int c = col0 + bj * HALF + 4 * n; const f32x4 wb = *(const f32x4*)(w0 + c);
#pragma unroll
                    for (int ai = 0; ai < 2; ++ai)
#pragma unroll
                        for (int m = 0; m < 4; ++m) { f32x4 v = acc[ai][bj][m][n] + wb;
#pragma unroll
                            for (int j = 0; j < 4; ++j) { const float x = v[j];
                                const float sp = fmaxf(-x, 0.f) + __logf(1.f + __expf(-fabsf(x))); v[j] = __expf(-__expf(-sp - 0.5f)); }
                            *(f32x4*)(DEC + (size_t)(row0 + ai * HALF + m * 16) * 4096 + c) = v; } }
        } else if (pn < 32) {
            const int col0 = (pn - 16) * BM + wc * 32 + 8 * fq;
#pragma unroll
            for (int bj = 0; bj < 2; ++bj) { const int c = col0 + bj * HALF; const f32x4 b0 = *(const f32x4*)(a0 + c), b1 = *(const f32x4*)(a0 + c + 4);
#pragma unroll
                for (int ai = 0; ai < 2; ++ai)
#pragma unroll
                    for (int m = 0; m < 4; ++m) { f32x4 v0 = acc[ai][bj][m][0] + b0, v1 = acc[ai][bj][m][1] + b1;
#pragma unroll
                        for (int j = 0; j < 4; ++j) { v0[j] = sigmoidf_(v0[j]); v1[j] = sigmoidf_(v1[j]); }
                        *(u32x4*)(ASB + (size_t)(row0 + ai * HALF + m * 16) * 4096 + c) = pack8(v0, v1); } }
        } else {
            const int col0 = (pn - 32) * BM + wc * 32 + 8 * fq;
#pragma unroll
            for (int ai = 0; ai < 2; ++ai)
#pragma unroll
                for (int m = 0; m < 4; ++m) { bf16_t* rowp = GB + (size_t)(row0 + ai * HALF + m * 16) * D + col0;
#pragma unroll
                    for (int bj = 0; bj < 2; ++bj) *(u32x4*)(rowp + bj * HALF) = pack8(acc[ai][bj][m][0], acc[ai][bj][m][1]); }
        }
    }
};
struct EpiF32B {
    static constexpr bool PERM = false;
    float* C; int ldc; const float* bias;
    __device__ __forceinline__ void operator()(const f32x4 (&acc)[2][2][4][2], const Unit& u, int wr, int wc, int fr, int fq) const {
        const int row0 = u.pm * BM + wr * 64 + fr, col0 = u.pn * BM + wc * 32 + 4 * fq;
#pragma unroll
        for (int bj = 0; bj < 2; ++bj)
#pragma unroll
            for (int n = 0; n < 2; ++n) { const int c = col0 + bj * HALF + n * 16; const f32x4 bv = *(const f32x4*)(bias + c);
#pragma unroll
                for (int ai = 0; ai < 2; ++ai)
#pragma unroll
                    for (int m = 0; m < 4; ++m) *(f32x4*)(C + (size_t)(row0 + ai * HALF + m * 16) * ldc + c) = acc[ai][bj][m][n] + bv; }
    }
};
struct EpiBf16B {
    static constexpr bool PERM = true;
    bf16_t* O; int ldc; const float* bias;
    __device__ __forceinline__ void operator()(const f32x4 (&acc)[2][2][4][2], const Unit& u, int wr, int wc, int fr, int fq) const {
        const int row0 = u.pm * BM + wr * 64 + fr, col0 = u.pn * BM + wc * 32 + 8 * fq;
#pragma unroll
        for (int bj = 0; bj < 2; ++bj) { const int c = col0 + bj * HALF; const f32x4 b0 = *(const f32x4*)(bias + c), b1 = *(const f32x4*)(bias + c + 4);
#pragma unroll
            for (int ai = 0; ai < 2; ++ai)
#pragma unroll
                for (int m = 0; m < 4; ++m) *(u32x4*)(O + (size_t)(row0 + ai * HALF + m * 16) * ldc + c) = pack8(acc[ai][bj][m][0] + b0, acc[ai][bj][m][1] + b1); }
    }
};
struct EpiFilt {
    static constexpr bool PERM = false;
    float* F;
    __device__ __forceinline__ void operator()(const f32x4 (&acc)[2][2][4][2], const Unit& u, int wr, int wc, int fr, int fq) const {
        const int row0 = u.pm * BM + wr * 64 + fr, col0 = u.pn * BM + wc * 32 + 4 * fq;
        const float dmin = -3.0701134573253944f, dmax = -15.350567286626972f;
#pragma unroll
        for (int ai = 0; ai < 2; ++ai)
#pragma unroll
            for (int m = 0; m < 4; ++m) { const int r = row0 + ai * HALF + m * 16; const int ch = r & 2047;
                const float delta = fabsf(dmin + (float)ch * ((dmax - dmin) / 2047.f));
#pragma unroll
                for (int bj = 0; bj < 2; ++bj)
#pragma unroll
                    for (int n = 0; n < 2; ++n) { const int c = col0 + bj * HALF + n * 16; f32x4 v = acc[ai][bj][m][n];
#pragma unroll
                        for (int j = 0; j < 4; ++j) v[j] *= __expf(-((float)(c + j) * (1.f / 8191.f)) * delta);
                        *(f32x4*)(F + (size_t)r * L + c) = v; } }
    }
};
struct EpiRes {
    static constexpr bool PERM = false;
    const float* res; float* out; const float* gate; const float* bias;
    __device__ __forceinline__ void operator()(const f32x4 (&acc)[2][2][4][2], const Unit& u, int wr, int wc, int fr, int fq) const {
        const int row0 = u.pm * BM + wr * 64 + fr, col0 = u.pn * BM + wc * 32 + 4 * fq;
#pragma unroll
        for (int bj = 0; bj < 2; ++bj)
#pragma unroll
            for (int n = 0; n < 2; ++n) { const int c = col0 + bj * HALF + n * 16; const f32x4 gv = *(const f32x4*)(gate + c);
                f32x4 bv = (f32x4){0.f, 0.f, 0.f, 0.f}; if (bias) bv = *(const f32x4*)(bias + c);
#pragma unroll
                for (int ai = 0; ai < 2; ++ai)
#pragma unroll
                    for (int m = 0; m < 4; ++m) { const size_t o = (size_t)(row0 + ai * HALF + m * 16) * D + c;
                        const f32x4 rv = *(const f32x4*)(res + o); *(f32x4*)(out + o) = rv + gv * (acc[ai][bj][m][n] + bv); } }
    }
};
struct EpiSwi {
    static constexpr bool PERM = true;
    bf16_t* H;
    __device__ __forceinline__ void operator()(const f32x4 (&acc)[2][2][4][2], const Unit& u, int wr, int wc, int fr, int fq) const {
        const int row0 = u.pm * BM + wr * 64 + fr, col0 = u.pn * HALF + wc * 32 + 8 * fq;
#pragma unroll
        for (int ai = 0; ai < 2; ++ai)
#pragma unroll
            for (int m = 0; m < 4; ++m) { f32x4 v0, v1;
#pragma unroll
                for (int j = 0; j < 4; ++j) { const float a0 = acc[ai][0][m][0][j], a1 = acc[ai][0][m][1][j];
                    v0[j] = a0 * sigmoidf_(a0) * acc[ai][1][m][0][j]; v1[j] = a1 * sigmoidf_(a1) * acc[ai][1][m][1][j]; }
                *(u32x4*)(H + (size_t)(row0 + ai * HALF + m * 16) * FF + col0) = pack8(v0, v1); }
    }
};

template <class Epi>
__device__ __forceinline__ void gemm_phase(LAS unsigned char* lds, const Gemm g, const StaticOrder& S, const Epi& E) {
    const int tid = otid(), wid = __builtin_amdgcn_readfirstlane(tid >> 6), lane = tid & 63, wr = wid >> 2, wc = wid & 3, fr = lane & 15, fq = lane >> 4;
    const int K = g.K, nt = K / BK;
    unsigned voffA[2], voffB[2];
#pragma unroll
    for (int i = 0; i < 2; ++i) { int R, C; stage_rc(tid * 16 + i * 8192, R, C); const int Rb = Epi::PERM ? ((R & ~31) + perm32(R & 31)) : R;
        voffA[i] = (unsigned)(R * K + C) * 2u; voffB[i] = (unsigned)(Rb * K + C) * 2u; }
    const size_t kstep = (size_t)(BK * 2);
    const size_t hstep = (size_t)HALF * K * 2;
    const size_t tstep = 2 * hstep;
    const unsigned ldsw = (unsigned)wid * 1024u;
    const int aoff = lds_byte(wr * 64 + fr, fq * 8), boff = lds_byte(wc * 32 + fr, fq * 8);
#define PG8_SA(b, h) (((b) * 2 + (h)) * HTB)
#define PG8_SB(b, h) ((4 + (b) * 2 + (h)) * HTB)
#define PG8_STAGE(bufoff, gbase, voff) do { _Pragma("unroll") for (int _i = 0; _i < 2; ++_i) \
        __builtin_amdgcn_global_load_lds((const unsigned*)((const char*)(gbase) + (voff)[_i]), (LAS unsigned*)(lds + (bufoff) + ldsw + _i * 8192), 16, 0, 0); } while (0)
#define PG8_LDA(dst, b, h) do { _Pragma("unroll") for (int m = 0; m < 4; ++m) _Pragma("unroll") for (int k = 0; k < 2; ++k) dst[m][k] = *(const LAS bf16x8*)(lds + PG8_SA(b, h) + aoff + m * 2048 + k * 1024); } while (0)
#define PG8_LDB(dst, b, h) do { _Pragma("unroll") for (int n = 0; n < 2; ++n) _Pragma("unroll") for (int k = 0; k < 2; ++k) dst[n][k] = *(const LAS bf16x8*)(lds + PG8_SB(b, h) + boff + n * 2048 + k * 1024); } while (0)
#define PG8_MMA(ai, bj, At, Bt) do { __builtin_amdgcn_s_setprio(1); _Pragma("unroll") for (int m = 0; m < 4; ++m) _Pragma("unroll") for (int n = 0; n < 2; ++n) _Pragma("unroll") for (int k = 0; k < 2; ++k) \
        acc[ai][bj][m][n] = __builtin_amdgcn_mfma_f32_16x16x32_bf16(Bt[n][k], At[m][k], acc[ai][bj][m][n], 0, 0, 0); __builtin_amdgcn_s_setprio(0); } while (0)
#define PG8_WAIT_V(n) asm volatile("s_waitcnt vmcnt(" #n ")" ::: "memory")
#define PG8_WAIT_L(n) asm volatile("s_waitcnt lgkmcnt(" #n ")" ::: "memory")
#define PG8_BAR __builtin_amdgcn_s_barrier()
#define PG8_SCHED __builtin_amdgcn_sched_barrier(0)
    Unit cur, nxt; int ui = 0;
    if (!S.next(0, cur)) return;
    f32x4 acc[2][2][4][2];
#pragma unroll
    for (int a = 0; a < 2; ++a)
#pragma unroll
        for (int b = 0; b < 2; ++b)
#pragma unroll
            for (int m = 0; m < 4; ++m)
#pragma unroll
                for (int n = 0; n < 2; ++n) acc[a][b][m][n] = (f32x4){0.f, 0.f, 0.f, 0.f};
    bf16x8 At[4][2], B0[2][2], B1[2][2];
    const char* cA = (const char*)g.A + (size_t)aidx(g.amode, cur.pn) * g.astride + (size_t)cur.pm * tstep; const char* cB = (const char*)g.Bt + (size_t)cur.pn * tstep;
    PG8_STAGE(PG8_SB(0, 0), cB, voffB); PG8_STAGE(PG8_SA(0, 0), cA, voffA); PG8_STAGE(PG8_SB(0, 1), cB + hstep, voffB); PG8_STAGE(PG8_SA(0, 1), cA + hstep, voffA);
    if (wr == 1) PG8_BAR;
    PG8_WAIT_V(4); PG8_BAR;
    PG8_STAGE(PG8_SB(1, 0), cB + kstep, voffB); PG8_STAGE(PG8_SA(1, 0), cA + kstep, voffA); PG8_STAGE(PG8_SB(1, 1), cB + hstep + kstep, voffB);
    PG8_WAIT_V(6); PG8_BAR;
    for (;;) {
        const bool has_next = S.next(ui + 1, nxt);
        const char* nA = has_next ? (const char*)g.A + (size_t)aidx(g.amode, nxt.pn) * g.astride + (size_t)nxt.pm * tstep : cA; const char* nB = has_next ? (const char*)g.Bt + (size_t)nxt.pn * tstep : cB;
        for (int t = 0; t < nt; t += 2) {
            const bool last = (t == nt - 2);
            const char* a1 = cA + (size_t)(t + 1) * kstep;
            const char* a2 = last ? nA : cA + (size_t)(t + 2) * kstep; const char* b2 = last ? nB : cB + (size_t)(t + 2) * kstep;
            const char* a3 = a2 + kstep; const char* b3 = b2 + kstep;
            PG8_LDB(B0, 0, 0); PG8_SCHED; PG8_LDA(At, 0, 0); PG8_STAGE(PG8_SA(1, 1), a1 + hstep, voffA);
            PG8_WAIT_L(8); PG8_BAR; PG8_WAIT_L(0); PG8_MMA(0, 0, At, B0); PG8_BAR; PG8_SCHED;
            PG8_LDB(B1, 0, 1); PG8_STAGE(PG8_SB(0, 0), b2, voffB);
            PG8_BAR; PG8_WAIT_L(0); PG8_MMA(0, 1, At, B1); PG8_BAR;
            PG8_LDA(At, 0, 1); PG8_STAGE(PG8_SA(0, 0), a2, voffA);
            PG8_BAR; PG8_WAIT_L(0); PG8_MMA(1, 0, At, B0); PG8_BAR; PG8_SCHED;
            PG8_STAGE(PG8_SB(0, 1), b2 + hstep, voffB);
            PG8_WAIT_V(6); PG8_BAR; PG8_MMA(1, 1, At, B1); PG8_BAR;
            PG8_LDB(B0, 1, 0); PG8_SCHED; PG8_LDA(At, 1, 0); PG8_STAGE(PG8_SA(0, 1), a2 + hstep, voffA);
            PG8_WAIT_L(8); PG8_BAR; PG8_WAIT_L(0); PG8_MMA(0, 0, At, B0); PG8_BAR; PG8_SCHED;
            PG8_LDB(B1, 1, 1); PG8_STAGE(PG8_SB(1, 0), b3, voffB);
            PG8_BAR; PG8_WAIT_L(0); PG8_MMA(0, 1, At, B1); PG8_BAR;
            PG8_LDA(At, 1, 1); PG8_STAGE(PG8_SA(1, 0), a3, voffA);
            PG8_BAR; PG8_WAIT_L(0); PG8_MMA(1, 0, At, B0); PG8_BAR; PG8_SCHED;
            PG8_STAGE(PG8_SB(1, 1), b3 + hstep, voffB);
            PG8_WAIT_V(6); PG8_BAR; PG8_MMA(1, 1, At, B1); PG8_BAR;
        }
        E(acc, cur, wr, wc, fr, fq);
        if (!has_next) break;
#pragma unroll
        for (int a = 0; a < 2; ++a)
#pragma unroll
            for (int b = 0; b < 2; ++b)
#pragma unroll
                for (int m = 0; m < 4; ++m)
#pragma unroll
                    for (int n = 0; n < 2; ++n) acc[a][b][m][n] = (f32x4){0.f, 0.f, 0.f, 0.f};
        cur = nxt; cA = nA; cB = nB; ++ui;
    }
    PG8_WAIT_V(0);
    if (wr == 0) PG8_BAR;
    PG8_BAR;
#undef PG8_SA
#undef PG8_SB
#undef PG8_STAGE
#undef PG8_LDA
#undef PG8_LDB
#undef PG8_MMA
#undef PG8_WAIT_V
#undef PG8_WAIT_L
#undef PG8_BAR
#undef PG8_SCHED
}
}

__device__ __forceinline__ void transpose_load(const float* W, int ldw, int k0, int n0, int lane, float (&tv)[32]) {
    const float* wp = W + (size_t)(k0 + (lane >> 5)) * ldw + n0 + (lane & 31);
#pragma unroll
    for (int i = 0; i < 32; ++i) tv[i] = __builtin_nontemporal_load(wp + (size_t)(2 * i) * ldw);
}
__device__ __forceinline__ void transpose_finish(bf16_t* WT, int ldt, int drow0, int dcol0, LAS float* scr, int lane, const float (&tv)[32]) {
#pragma unroll
    for (int i = 0; i < 32; ++i) scr[(2 * i + (lane >> 5)) * 33 + (lane & 31)] = tv[i];
    LDS_WAIT();
    const int c = lane & 7;
#pragma unroll
    for (int j = 0; j < 4; ++j) { const int n = (lane >> 3) + 8 * j; const LAS float* s = scr + (8 * c) * 33 + n;
        u32x4 o; o.x = pk2(s[0 * 33], s[1 * 33]); o.y = pk2(s[2 * 33], s[3 * 33]); o.z = pk2(s[4 * 33], s[5 * 33]); o.w = pk2(s[6 * 33], s[7 * 33]);
        *(u32x4*)(WT + (size_t)(drow0 + n) * ldt + dcol0 + 8 * c) = o; }
    LDS_WAIT();
}
__device__ __forceinline__ void transpose_item(const float* W, int ldw, bf16_t* WT, int ldt, int k0, int n0, int drow0, int dcol0, LAS float* scr, int lane) {
    float tv[32];
    transpose_load(W, ldw, k0, n0, lane, tv);
    transpose_finish(WT, ldt, drow0, dcol0, scr, lane, tv);
}
__device__ __forceinline__ void transpose_mat(const float* W, int N, bf16_t* WT, int ldt, int rowmode, int row_off, int it, LAS float* scr, int lane) {
    const int nblk = N / 32, kb = it / nblk, nb = it % nblk, k0 = 64 * kb, n0 = 32 * nb;
    const int drow0 = rowmode == 0 ? row_off + n0 : (n0 >> 7) * 256 + (n0 & 127) + row_off;
    transpose_item(W, N, WT, ldt, k0, n0, drow0, k0, scr, lane);
}


#define XB_TMO      128
#define XB_XCNT(j)  (256  + 64 * (j))
#define XB_XSUB(j)  (1280 + 64 * (j))
#define XB_XGEN(j)  (2304 + 64 * (j))
#define XB_TOP      3328
#define XB_TOPGEN   3392
#define XCD_BAR_WORDS 3456
#define XB_SPIN_CAP (1u << 18)
__device__ __forceinline__ unsigned xb_ld(unsigned* p)              { return __hip_atomic_load(p, __ATOMIC_RELAXED, __HIP_MEMORY_SCOPE_AGENT); }
__device__ __forceinline__ unsigned xb_add(unsigned* p, unsigned v) { return __hip_atomic_fetch_add(p, v, __ATOMIC_RELAXED, __HIP_MEMORY_SCOPE_AGENT); }
__device__ __forceinline__ unsigned xb_xcc_id() { return (unsigned)__builtin_amdgcn_s_getreg((3 << 11) | 20) & 0xFu; }
#define XB_SPIN(cond, bar) do { unsigned _sp = 0; while (cond) { __builtin_amdgcn_s_sleep(1); \
    if ((++_sp & 255u) == 0u) { if (xb_ld(&(bar)[XB_TMO])) break; if (_sp > XB_SPIN_CAP) { atomicAdd(&(bar)[XB_TMO], 1u); break; } } } } while (0)
struct XcdBarrier { unsigned* bar; unsigned x; volatile LAS unsigned* st; };
__device__ __forceinline__ XcdBarrier xcd_barrier_post(unsigned* bar, volatile LAS unsigned* st) {
    XcdBarrier b; b.bar = bar; b.x = xb_xcc_id(); b.st = st;
    if (threadIdx.x == 0) (void)xb_add(&bar[XB_XCNT(b.x)], 1u);
    return b;
}
__device__ __forceinline__ void xcd_barrier_complete(unsigned* bar, unsigned x, unsigned& nloc, unsigned& nx) {
    const unsigned Gt = gridDim.x * gridDim.y * gridDim.z;
    unsigned sum, cnt, mine, sp = 0u;
    for (;;) {
        sum = 0u; cnt = 0u; mine = 0u;
#pragma unroll
        for (unsigned j = 0; j < 16; ++j) { const unsigned c = xb_ld(&bar[XB_XCNT(j)]); sum += c; cnt += (c > 0u) ? 1u : 0u; mine = (j == x) ? c : mine; }
        if (sum == Gt) break;
        __builtin_amdgcn_s_sleep(1);
        if ((++sp & 255u) == 0u) { if (xb_ld(&bar[XB_TMO])) break; if (sp > XB_SPIN_CAP) { atomicAdd(&bar[XB_TMO], 1u); break; } }
    }
    nloc = mine > 0u ? mine : 1u; nx = cnt > 0u ? cnt : 1u;
}
__device__ __forceinline__ void xcd_barrier(const XcdBarrier& b) {
    asm volatile("s_waitcnt vmcnt(0)" ::: "memory");
    __syncthreads();
    if (threadIdx.x == 0) {
        unsigned* bar = b.bar;
        __builtin_amdgcn_s_waitcnt(0);
        unsigned nloc = b.st[0], nx = b.st[1];
        if (nloc == 0u) { xcd_barrier_complete(bar, b.x, nloc, nx); b.st[0] = nloc; b.st[1] = nx; }
        const unsigned old = xb_add(&bar[XB_XSUB(b.x)], 1u);
        const unsigned gen = old / nloc;
        if (old + 1u == (gen + 1u) * nloc) {
            __builtin_amdgcn_fence(__ATOMIC_RELEASE, "agent");
            asm volatile("s_waitcnt vmcnt(0)" ::: "memory");
            const unsigned og = xb_add(&bar[XB_TOP], 1u);
            const unsigned tg = og / nx;
            if (og + 1u == (tg + 1u) * nx) xb_add(&bar[XB_TOPGEN], 1u);
            else XB_SPIN(xb_ld(&bar[XB_TOPGEN]) == tg, bar);
            __builtin_amdgcn_fence(__ATOMIC_ACQUIRE, "agent");
            xb_add(&bar[XB_XGEN(b.x)], 1u);
            asm volatile("s_waitcnt vmcnt(0)" ::: "memory");
        } else {
            XB_SPIN(xb_ld(&bar[XB_XGEN(b.x)]) == gen, bar);
            __builtin_amdgcn_fence(__ATOMIC_ACQUIRE, "agent");
            asm volatile("s_waitcnt vmcnt(0)" ::: "memory");
        }
    }
    __syncthreads();
}

__global__ void __launch_bounds__(NTHR, 2) mega(Args a) {
    extern __shared__ __attribute__((aligned(16))) unsigned char lds_raw[];
    cg::grid_group grid = cg::this_grid();
    LAS unsigned char* lds = (LAS unsigned char*)lds_raw;
    LAS float* smf = (LAS float*)lds_raw;
    const int G = gridDim.x, bid = blockIdx.x, NGW = G * 8;
    const size_t GT = (size_t)G * NTHR;
#define PH_VARS const int tid = otid(), lane = tid & 63, wave = __builtin_amdgcn_readfirstlane(tid >> 6); const int gw = bid * 8 + wave; const size_t gtid = (size_t)bid * NTHR + tid; (void)lane; (void)gw; (void)gtid; (void)wave;
#define MOD ((float*)(a.ws + WS_MOD))
#define RSTD ((float*)(a.ws + WS_RSTD))
#define TW1 ((f32x2*)(a.ws + WS_TW1))
#define TW2 ((f32x2*)(a.ws + WS_TW2))
#define HIDP ((bf16_t*)(a.ws + WS_HIDP))
#define WOUTP ((bf16_t*)(a.ws + WS_WOUTP))
#define WCAT ((bf16_t*)(a.ws + WS_WCAT))
#define W2CAT ((bf16_t*)(a.ws + WS_W2CAT))
#define WO ((bf16_t*)(a.ws + WS_WO))
#define WF13_0 ((bf16_t*)(a.ws + WS_WF13_0))
#define WF2_0 ((bf16_t*)(a.ws + WS_WF2_0))
#define XM ((bf16_t*)(a.ws + WS_XM))
#define Y0 ((bf16_t*)(a.ws + WS_Y0))
#define Y1 ((bf16_t*)(a.ws + WS_Y1))
#define AO ((bf16_t*)(a.ws + WS_AO))
#define RB ((bf16_t*)(a.ws + WS_RB))
#define VB ((bf16_t*)(a.ws + WS_VB))
#define KF ((float*)(a.ws + WS_KF))
#define L1B ((bf16_t*)(a.ws + WS_L1))
#define DEC ((float*)(a.ws + WS_DEC))
#define ASB ((bf16_t*)(a.ws + WS_ASB))
#define GB ((bf16_t*)(a.ws + WS_GB))
#define WHYIN ((bf16_t*)(a.ws + WS_WHYIN))
#define WHYOUT ((bf16_t*)(a.ws + WS_WHYOUT))
#define WF13_1 ((bf16_t*)(a.ws + WS_WF13_1))
#define WF2_1 ((bf16_t*)(a.ws + WS_WF2_1))
#define A2 ((bf16_t*)(a.ws + WS_A2))
#define UPRE ((bf16_t*)(a.ws + WS_UPRE))
#define HID ((bf16_t*)(a.ws + WS_HID))
#define ZT ((float*)(a.ws + WS_ZT))
#define FILT ((float*)(a.ws + WS_FILT))
#define VVT ((float*)(a.ws + WS_VVT))
#define X0T ((float*)(a.ws + WS_X0T))
#define XL (a.out)
#define IN(k) ldp_(tbl, k)

    volatile LAS unsigned* xb_st = (volatile LAS unsigned*)(lds_raw + XB_LDS_OFF);
    if (threadIdx.x < 4) xb_st[threadIdx.x] = 0u;
    __syncthreads();
    const XcdBarrier xbar = xcd_barrier_post((unsigned*)(a.ws + WS_BAR), xb_st);
#define GRID_BAR() xcd_barrier(xbar)
    unsigned long long* tbl = (unsigned long long*)(a.ws + WS_TBL) + (size_t)blockIdx.x * 64;
    if (threadIdx.x == 0) {
#pragma unroll
        for (int i = 0; i < 45; ++i) tbl[i] = (unsigned long long)a.in[i];
    }
    __syncthreads();
    for (int rep_ = 0; rep_ < 1 + (int)((REPMASK >> 0) & 1u); ++rep_) { PH_VARS
        const float* cv = IN(1); const float* ccv = IN(3); const float* W = IN(4); const float* Bv = IN(5);
        for (int i = tid; i < D; i += NTHR) { const float v = cv[i]; smf[i] = v / (1.f + expf(-v)); const float w = ccv[i]; smf[D + i] = w / (1.f + expf(-w)); }
        __syncthreads();
        LAS float* red = smf + 2 * D;
        for (int cb = bid; cb < 256; cb += G) {
            const int col0 = cb * 48, c4 = tid % 12, rg = tid / 12;
            if (rg < 42) {
                f32x4 aL0 = (f32x4){0.f, 0.f, 0.f, 0.f}, aC0 = aL0;
                const float* w0p = W + col0 + 4 * c4;
#pragma unroll 7
                for (int r = rg; r < D; r += 42) {
                    const f32x4 x0 = *(const f32x4*)(w0p + (size_t)r * 12288);
                    const float sl = smf[r], sc = smf[D + r];
                    aL0 += x0 * sl; aC0 += x0 * sc;
                }
#pragma unroll
                for (int j = 0; j < 4; ++j) { red[(0 * 42 + rg) * 48 + 4 * c4 + j] = aL0[j]; red[(1 * 42 + rg) * 48 + 4 * c4 + j] = aC0[j]; }
            }
            __syncthreads();
            if (tid < 96) { const int which = tid / 48, cl = tid % 48; float s = 0.f;
                for (int q = 0; q < 42; ++q) s += red[(which * 42 + q) * 48 + cl];
                s += Bv[col0 + cl]; MOD[which * 12288 + col0 + cl] = s; }
            __syncthreads();
        }
    }
    for (int rep_ = 0; rep_ < 1 + (int)((REPMASK >> 0) & 1u); ++rep_) { PH_VARS
        const float* xin_ = IN(0); const float* cin_ = IN(2);
        for (int r = gw; r < MT; r += NGW) { const float* src = r < L ? xin_ + (size_t)r * D : cin_ + (size_t)(r - L) * D; float s = 0.f;
#pragma unroll
            for (int j = 0; j < 8; ++j) { const f32x4 v = *(const f32x4*)(src + 4 * lane + 256 * j); s += v.x * v.x + v.y * v.y + v.z * v.z + v.w * v.w; }
            s = wave_sum(s); if (lane == 0) RSTD[r] = 1.0f / sqrtf(s * (1.f / D) + 1e-6f); }
    }
    for (int rep_ = 0; rep_ < 1 + (int)((REPMASK >> 0) & 1u); ++rep_) { PH_VARS
        for (size_t k = gtid; k < 8192; k += GT) { const float t1 = (float)k * (1.f / 4096.f), t2 = (float)k * (1.f / 8192.f);
            TW1[k] = (f32x2){cospif(t1), -sinpif(t1)}; TW2[k] = (f32x2){cospif(t2), -sinpif(t2)}; }
    }
    if (a.ws == nullptr) grid.sync();
    GRID_BAR();

    for (int rep_ = 0; rep_ < 1 + (int)((REPMASK >> 1) & 1u); ++rep_) { PH_VARS
      if (wave >= 4) {
        const size_t gtid4 = (size_t)bid * 256 + (tid - 256), GT4 = (size_t)G * 256;
        for (size_t i = gtid4; i < (size_t)2 * 64 * D / 8; i += GT4) { const size_t e = i * 8; const int blk = (int)(e / (64 * D)); const size_t off = e % (64 * D);
            *(u32x4*)(WCAT + (size_t)(blk == 0 ? 6336 : 6592) * D + off) = (u32x4){0u, 0u, 0u, 0u}; }
        const float* w2 = IN(18); const float* a2 = IN(21); const float* g2 = IN(23);
#pragma unroll 4
        for (size_t i = gtid4; i < (size_t)10240 * 256; i += GT4) { const int n = (int)(i % 10240), k = (int)(i / 10240); float v = 0.f;
            if (n < 8192) { const int nn = n & 4095, d = nn >> 11, c = nn & 2047, kk = k - 96 * d; const float* src = n < 4096 ? w2 : a2;
                if (kk >= 0 && kk < 96) v = src[((size_t)d * 96 + kk) * D + c]; }
            else v = g2[(size_t)k * D + (n - 8192)];
            W2CAT[(size_t)n * 256 + k] = f2bf(v); }
        LAS float* scr = smf + (wave - 4) * (64 * 33);
        constexpr int I_SQ = 32 * 64, I_L = 32 * 3, I_G1 = 32 * 8, I_F = 32 * 176, I_F2 = 88 * 64;
        constexpr int NIT = 3 * I_SQ + 4 * I_L + I_G1; (void)I_F; (void)I_F2;
        for (int it = bid * 4 + (wave - 4); it < NIT; it += G * 4) {
            int r = it;
            if (r < I_SQ) { transpose_mat(IN(12), D, WCAT, D, 0, 0, r, scr, lane); continue; } r -= I_SQ;
            if (r < I_SQ) { transpose_mat(IN(13), D, WCAT, D, 0, 2048, r, scr, lane); continue; } r -= I_SQ;
            if (r < I_SQ) { transpose_mat(IN(14), D, WCAT, D, 0, 4096, r, scr, lane); continue; } r -= I_SQ;
            if (r < I_L) { transpose_mat(IN(17), 96, WCAT, D, 0, 6144, r, scr, lane); continue; } r -= I_L;
            if (r < I_L) { transpose_mat(IN(17) + (size_t)D * 96, 96, WCAT, D, 0, 6240, r, scr, lane); continue; } r -= I_L;
            if (r < I_L) { transpose_mat(IN(20), 96, WCAT, D, 0, 6400, r, scr, lane); continue; } r -= I_L;
            if (r < I_L) { transpose_mat(IN(20) + (size_t)D * 96, 96, WCAT, D, 0, 6496, r, scr, lane); continue; } r -= I_L;
            transpose_mat(IN(22), 256, WCAT, D, 0, 6656, r, scr, lane);
        }
      } else
      for (int hh = 0; hh < 2; ++hh) {
        const int c0 = tid * 4 + 1024 * hh; const float* g1 = IN(6); const float* mu = IN(11); const float* xin_ = IN(0); const float* cin_ = IN(2);
        const f32x4 gv = *(const f32x4*)(g1 + c0);
        const f32x4 scL = *(const f32x4*)(MOD + 2048 + c0), shL = *(const f32x4*)(MOD + c0);
        const f32x4 scC = *(const f32x4*)(MOD + 12288 + 2048 + c0), shC = *(const f32x4*)(MOD + 12288 + c0);
        const f32x4 AL = gv * (scL + 1.f), AC = gv * (scC + 1.f);
        f32x4 muv[6];
#pragma unroll
        for (int m = 0; m < 6; ++m) muv[m] = *(const f32x4*)(mu + m * D + c0);
        const int q = c0 >> 9;
        for (int t0 = bid; t0 < MT; t0 += 3 * G) {
            f32x4 xv[3], xn[3]; float rs[3], rn[3]; bool vld[3], latv[3]; int tt[3];
#pragma unroll
            for (int j = 0; j < 3; ++j) {
                int t = t0 + j * G; if (t >= MT) t = t0; tt[j] = t;
                const bool lat = t < L; int tn = t; bool valid;
                if (lat) { const int col = t & 63, row = t >> 6;
                    if (q == 0) { valid = col > 0; tn = t - 1; } else if (q == 1) { valid = col < 63; tn = t + 1; } else if (q == 2) { valid = row > 0; tn = t - 64; } else { valid = row < 127; tn = t + 64; } }
                else { const int i = t - L; if (q < 2) { valid = i > 0; tn = t - 1; } else { valid = i < CT - 1; tn = t + 1; } }
                if (!valid) tn = t;
                const float* xp = lat ? xin_ + (size_t)t * D : cin_ + (size_t)(t - L) * D;
                const float* xq = lat ? xin_ + (size_t)tn * D : cin_ + (size_t)(tn - L) * D;
                xv[j] = *(const f32x4*)(xp + c0); xn[j] = *(const f32x4*)(xq + c0); rs[j] = RSTD[t]; rn[j] = RSTD[tn]; vld[j] = valid; latv[j] = lat;
            }
#pragma unroll
            for (int j = 0; j < 3; ++j) {
                if (j > 0 && t0 + j * G >= MT) continue;
                const f32x4 Am = latv[j] ? AL : AC, Sh = latv[j] ? shL : shC;
                const f32x4 h = xv[j] * rs[j] * Am + Sh;
                f32x4 hs = xn[j] * rn[j] * Am + Sh; if (!vld[j]) hs = (f32x4){0.f, 0.f, 0.f, 0.f};
                const f32x4 xx = hs - h;
#pragma unroll
                for (int m = 0; m < 6; ++m) { const f32x4 v = h + xx * muv[m]; u32x2 o; o.x = pk2(v.x, v.y); o.y = pk2(v.z, v.w);
                    *(u32x2*)(XM + (size_t)m * ((size_t)MT * D) + (size_t)tt[j] * D + c0) = o; }
            }
        }
      }
    }
    GRID_BAR();

    for (int rep_ = 0; rep_ < 1 + (int)((REPMASK >> 2) & 1u); ++rep_) { PH_VARS
        pg8::Gemm g{XM, WCAT, MT, 6912, D, 1, XM_STRIDE}; pg8::StaticOrder S; S.init(MT, 6912, G, bid);
        pg8::EpiP2 E{RB, KF, VB, L1B};
        pg8::gemm_phase<pg8::EpiP2>(lds, g, S, E);
        { const int ntile2 = (MT / 256) * (6912 / 256), nb2 = ntile2 - (ntile2 / G) * G;
          int b2 = bid, G2 = G; bool act2 = true;
          if (nb2 > 0 && nb2 < G) { b2 = bid - nb2; G2 = G - nb2; act2 = bid >= nb2; }
          if (act2) {
        const float* fw0 = IN(33); const float* fb0 = IN(34); const float* fw1 = IN(35); const float* fb1 = IN(36);
        const float* fw2 = IN(37); const float* fb2 = IN(38); const float* freq = IN(39);
        LAS float* zb = smf; LAS float* h1 = smf + 8 * 36; LAS float* h2 = h1 + 512;
        LAS float* lw0 = smf + 2048; LAS float* lw1 = lw0 + 33 * 64; LAS float* lw2 = lw1 + 64 * 64;
        for (int i = tid; i < 33 * 64; i += NTHR) lw0[i] = fw0[i];
        for (int i = tid; i < 64 * 64; i += NTHR) { lw1[i] = fw1[i]; lw2[i] = fw2[i]; }
        __syncthreads();
        const int tl = tid >> 6, j = tid & 63; const float fq_ = freq[j];
        for (int it = b2; it < 1024; it += G2) {
            const int t = it * 8 + tl;
            if (j < 33) { float z;
                if (j == 0) z = (float)t * (1.f / 8191.f);
                else { const int band = (j - 1) & 15; const float f = 1e-4f + (float)band * ((15.f - 1e-4f) / 15.f); const float w = (6.283185307179586f * (float)t) / 8192.f;
                    const float wp = (2.f * (float)t) / 8192.f;
                    z = j <= 16 ? cospif(f * wp) : -sinpif(f * wp); (void)w; }
                zb[tl * 36 + j] = z; }
            __syncthreads();
            float acc = fb0[j];
#pragma unroll 4
            for (int i = 0; i < 33; ++i) acc += zb[tl * 36 + i] * lw0[i * 64 + j];
            h1[tl * 64 + j] = sinpif(fq_ * acc * 0.3183098861837907f);
            __syncthreads();
            acc = fb1[j];
#pragma unroll 8
            for (int i = 0; i < 64; ++i) acc += h1[tl * 64 + i] * lw1[i * 64 + j];
            h2[tl * 64 + j] = sinpif(fq_ * acc * 0.3183098861837907f);
            __syncthreads();
            acc = fb2[j];
#pragma unroll 8
            for (int i = 0; i < 64; ++i) acc += h2[tl * 64 + i] * lw2[i * 64 + j];
            const float h3 = sinpif(fq_ * acc * 0.3183098861837907f);
            const bf16_t hi = f2bf(h3), lo = f2bf(h3 - bf2f(hi));
            bf16_t* o = HIDP + (size_t)t * 256 + j; o[0] = hi; o[64] = hi; o[128] = lo; o[192] = 0;
            __syncthreads();
        }
        const float* wout = IN(40);
        for (size_t i = (size_t)b2 * NTHR + tid; i < (size_t)4096 * 64; i += (size_t)G2 * NTHR) { const int c = (int)(i >> 6), jj = (int)(i & 63); const float w = wout[(size_t)jj * 4096 + c];
            const bf16_t hi = f2bf(w), lo = f2bf(w - bf2f(hi)); bf16_t* o = WOUTP + (size_t)c * 256 + jj; o[0] = hi; o[64] = lo; o[128] = hi; o[192] = 0; }
          } }
    }
    GRID_BAR();
    for (int rep_ = 0; rep_ < 1 + (int)((REPMASK >> 3) & 1u); ++rep_) { PH_VARS
        pg8::Gemm g{L1B, W2CAT, MT, 10240, 256, 2, L1_STRIDE}; pg8::StaticOrder S; S.init(MT, 10240, G, bid);
        pg8::EpiP3 E{DEC, ASB, GB, IN(16), IN(19)};
        pg8::gemm_phase<pg8::EpiP3>(lds, g, S, E);
    }
    GRID_BAR();

    for (int rep_ = 0; rep_ < 1 + (int)((REPMASK >> 4) & 1u); ++rep_) { PH_VARS
        constexpr int TC = 32, BUFSZ = 5 * TC * 64 + TC * 16;
        LAS float* ybuf = smf + 2 * BUFSZ;
        const float* k_k = IN(24); const float* k_a = IN(25);
        for (int job = bid; job < 256; job += G) {
            const int dir = job >> 7, head = (job & 127) >> 2, rg = job & 3;
            const int si = tid >> 4, j4 = (tid & 15) * 4, chb = head * 64 + j4;
            const f32x4 kkw = *(const f32x4*)(k_k + chb), kaw = *(const f32x4*)(k_a + chb);
            const int rl = tid >> 4, cgp = tid & 15;
            f32x2 s01 = (f32x2){0.f, 0.f}, s23 = (f32x2){0.f, 0.f};
            bf16_t* Yd = dir == 0 ? Y0 : Y1;
            f32x4 pk_, pdec, qk_, qdec; u32x2 pa, pr, pv, qa, qr, qv;
            const int sA = (tid & 255) >> 4, sB = sA + 16;
#define SCAN_ROW(n) ((n) < CT ? (dir == 0 ? L + (n) : L + CT - 1 - (n)) : (dir == 0 ? (n) - CT : L - 1 - ((n) - CT)))
#define SCAN_LOAD1(c, SI, K_, DEC_, A_, R_, V_) do { const int _row = SCAN_ROW((c) * TC + (SI)); \
                K_ = *(const f32x4*)(KF + (size_t)_row * D + chb); DEC_ = *(const f32x4*)(DEC + (size_t)_row * 4096 + dir * D + chb); \
                A_ = *(const u32x2*)(ASB + (size_t)_row * 4096 + dir * D + chb); R_ = *(const u32x2*)(RB + (size_t)_row * D + chb); \
                if ((tid & 15) < 4) V_ = *(const u32x2*)(VB + (size_t)_row * D + head * 64 + rg * 16 + j4); } while (0)
#define SCAN_STAGE1(b, SI, K_, DEC_, A_, R_, V_) do { LAS float* _B = smf + (b) * BUFSZ; \
                f32x4 _kk = K_ * kkw; float _ss = _kk.x * _kk.x + _kk.y * _kk.y + _kk.z * _kk.z + _kk.w * _kk.w; _ss = red16(_ss); \
                const float _inv = 1.f / fmaxf(sqrtf(_ss), 1e-12f); _kk = _kk * _inv; \
                const f32x4 _a = (f32x4){bflo(A_.x), bfhi(A_.x), bflo(A_.y), bfhi(A_.y)}; \
                const f32x4 _kd = K_ * ((_a - 1.f) * kaw + 1.f); const f32x4 _bb = _kk * _a; \
                const f32x4 _r = (f32x4){bflo(R_.x), bfhi(R_.x), bflo(R_.y), bfhi(R_.y)}; \
                *(LAS f32x4*)(_B + (SI) * 64 + j4) = _kk; *(LAS f32x4*)(_B + 2048 + (SI) * 64 + j4) = DEC_; *(LAS f32x4*)(_B + 4096 + (SI) * 64 + j4) = _bb; \
                *(LAS f32x4*)(_B + 6144 + (SI) * 64 + j4) = _kd; *(LAS f32x4*)(_B + 8192 + (SI) * 64 + j4) = _r; \
                if ((tid & 15) < 4) *(LAS f32x4*)(_B + 10240 + (SI) * 16 + j4) = (f32x4){bflo(V_.x), bfhi(V_.x), bflo(V_.y), bfhi(V_.y)}; } while (0)
#define SCAN_FLUSH(cb) do { if ((cb) * TC >= CT) { _Pragma("unroll") for (int _h = 0; _h < 2; ++_h) { const int _o = (tid & 255) + 256 * _h, _i = _o >> 4, _r16 = _o & 15; const int _row = SCAN_ROW((cb) * TC + _i); \
                const LAS f32x4* _yp = (const LAS f32x4*)(ybuf + ((cb) & 1) * 4096 + _o * 8); const f32x4 _qs = _yp[0] + _yp[1]; \
                Yd[(size_t)_row * D + head * 64 + rg * 16 + _r16] = f2bf((_qs.x + _qs.y) + (_qs.z + _qs.w)); } } } while (0)
#define SCAN_LOAD(c) do { SCAN_LOAD1(c, sA, pk_, pdec, pa, pr, pv); SCAN_LOAD1(c, sB, qk_, qdec, qa, qr, qv); } while (0)
#define SCAN_STAGE(b) do { SCAN_STAGE1(b, sA, pk_, pdec, pa, pr, pv); SCAN_STAGE1(b, sB, qk_, qdec, qa, qr, qv); } while (0)
            if (tid >= 256) { SCAN_LOAD(0); SCAN_STAGE(0); }
            __syncthreads();
            constexpr int NCH = MT / TC;
            constexpr int SC_ISQ = 32 * 64, SC_IIN = 32 * 192, SC_IF = 32 * 176, SC_IF2 = 88 * 64, SC_NIT = 2 * (2 * SC_IF + SC_IF2) + SC_IIN + 2 * SC_ISQ;
            float tvs[32];
#pragma unroll
            for (int i = 0; i < 32; ++i) tvs[i] = 0.f;
            for (int c = 0; c < NCH; ++c) {
                if (tid >= 256) {
                    if (c > 0) SCAN_FLUSH(c - 1);
                    if (c + 1 < NCH) SCAN_LOAD(c + 1);
                    LAS float* scr = smf + 2 * BUFSZ + 8192 + (wave - 4) * (64 * 33);
#pragma unroll
                    for (int ph = 0; ph < 2; ++ph) {
                        int r = ((c - 1 + ph) * G + bid) * 4 + (wave - 4);
                        if (r >= 0 && r < SC_NIT && (ph == 1 || c > 0)) {
                            const float* Wsrc; bf16_t* Wdst; int Nn, ldt, rowmode = 0, row_off = 0;
                            if (r < SC_IF) { Wsrc = IN(8); Wdst = WF13_0; Nn = FF; ldt = D; rowmode = 1; }
                            else if ((r -= SC_IF) < SC_IF) { Wsrc = IN(9); Wdst = WF13_0; Nn = FF; ldt = D; rowmode = 1; row_off = 128; }
                            else if ((r -= SC_IF) < SC_IF2) { Wsrc = IN(10); Wdst = WF2_0; Nn = D; ldt = FF; }
                            else if ((r -= SC_IF2) < SC_IIN) { Wsrc = IN(29); Wdst = WHYIN; Nn = 6144; ldt = D; }
                            else if ((r -= SC_IIN) < SC_ISQ) { Wsrc = IN(42); Wdst = WHYOUT; Nn = D; ldt = D; }
                            else if ((r -= SC_ISQ) < SC_IF) { Wsrc = IN(8) + (size_t)D * FF; Wdst = WF13_1; Nn = FF; ldt = D; rowmode = 1; }
                            else if ((r -= SC_IF) < SC_IF) { Wsrc = IN(9) + (size_t)D * FF; Wdst = WF13_1; Nn = FF; ldt = D; rowmode = 1; row_off = 128; }
                            else if ((r -= SC_IF) < SC_IF2) { Wsrc = IN(10) + (size_t)FF * D; Wdst = WF2_1; Nn = D; ldt = FF; }
                            else { r -= SC_IF2; Wsrc = IN(15); Wdst = WO; Nn = D; ldt = D; }
                            const int nblk = Nn / 32, kb = r / nblk, nbq = r % nblk, k0 = 64 * kb, n0 = 32 * nbq;
                            const int drow0 = rowmode == 0 ? row_off + n0 : (n0 >> 7) * 256 + (n0 & 127) + row_off;
                            if (ph == 0) transpose_finish(Wdst, ldt, drow0, k0, scr, lane, tvs); else transpose_load(Wsrc, Nn, k0, n0, lane, tvs);
                        }
                    }
                    if (c + 1 < NCH) SCAN_STAGE((c + 1) & 1);
                } else {
                    const LAS float* B = smf + (c & 1) * BUFSZ + 4 * cgp; const LAS float* Bv = smf + (c & 1) * BUFSZ + 10240 + rl;
                    LAS float* yb = ybuf + (c & 1) * 4096 + rl * 8 + (cgp & 7);
                    f32x4 kk = *(const LAS f32x4*)(B), w = *(const LAS f32x4*)(B + 2048), bb = *(const LAS f32x4*)(B + 4096), kd = *(const LAS f32x4*)(B + 6144), rr = *(const LAS f32x4*)(B + 8192);
                    float vt = Bv[0];
#pragma unroll 4
                    for (int i = 0; i < TC; ++i) {
                        const int in = (i + 1 < TC) ? i + 1 : i;
                        const f32x4 kk_n = *(const LAS f32x4*)(B + in * 64), w_n = *(const LAS f32x4*)(B + 2048 + in * 64), bb_n = *(const LAS f32x4*)(B + 4096 + in * 64);
                        const f32x4 kd_n = *(const LAS f32x4*)(B + 6144 + in * 64), rr_n = *(const LAS f32x4*)(B + 8192 + in * 64); const float vt_n = Bv[in * 16];
                        f32x2 pp = s01 * (f32x2){kk.x, kk.y}; pp = s23 * (f32x2){kk.z, kk.w} + pp;
                        float p = pp.x + pp.y; p = red16(p); const float sa = -p;
                        const f32x2 vk01 = (f32x2){kd.x, kd.y} * vt, vk23 = (f32x2){kd.z, kd.w} * vt;
                        s01 = s01 * (f32x2){w.x, w.y} + ((f32x2){bb.x, bb.y} * sa + vk01);
                        s23 = s23 * (f32x2){w.z, w.w} + ((f32x2){bb.z, bb.w} * sa + vk23);
                        f32x2 yy = s01 * (f32x2){rr.x, rr.y}; yy = s23 * (f32x2){rr.z, rr.w} + yy;
                        { float yp = yy.x + yy.y; yp += dpp<0x128>(yp); yb[i * 128] = yp; }
                        kk = kk_n; w = w_n; bb = bb_n; kd = kd_n; rr = rr_n; vt = vt_n;
                    }
                }
                __syncthreads();
            }
            if (tid >= 256) SCAN_FLUSH(NCH - 1);
            __syncthreads();
#undef SCAN_FLUSH
#undef SCAN_ROW
#undef SCAN_LOAD
#undef SCAN_STAGE
#undef SCAN_LOAD1
#undef SCAN_STAGE1
        }
    }
    GRID_BAR();

    for (int rep_ = 0; rep_ < 1 + (int)((REPMASK >> 5) & 1u); ++rep_) { PH_VARS
        const float* k_a = IN(25); const float* r_k = IN(26); const float* lw = IN(27); const float* lb = IN(28);
        for (int task = gw; task < L * 8; task += NGW) {
            const int t = task >> 3, c = (task & 7) * 256 + lane * 4; const size_t o = (size_t)t * D + c;
            const u32x2 y0b = *(const u32x2*)(Y0 + o), y1b = *(const u32x2*)(Y1 + o);
            const f32x4 y = (f32x4){bflo(y0b.x), bfhi(y0b.x), bflo(y0b.y), bfhi(y0b.y)} + (f32x4){bflo(y1b.x), bfhi(y1b.x), bflo(y1b.y), bfhi(y1b.y)};
            const float mean = red16(y.x + y.y + y.z + y.w) * (1.f / 64.f); const f32x4 dl = y - mean;
            const float var = red16(dl.x * dl.x + dl.y * dl.y + dl.z * dl.z + dl.w * dl.w) * (1.f / 64.f);
            const f32x4 yn = dl * (1.0f / sqrtf(var + 64e-5f)) * *(const f32x4*)(lw + c) + *(const f32x4*)(lb + c);
            const u32x2 rb = *(const u32x2*)(RB + o), vb = *(const u32x2*)(VB + o), gb = *(const u32x2*)(GB + o);
            const u32x2 a0b = *(const u32x2*)(ASB + (size_t)t * 4096 + c), a1b = *(const u32x2*)(ASB + (size_t)t * 4096 + D + c);
            const f32x4 k = *(const f32x4*)(KF + o), ka = *(const f32x4*)(k_a + c), rk = *(const f32x4*)(r_k + c);
            const f32x4 r = (f32x4){bflo(rb.x), bfhi(rb.x), bflo(rb.y), bfhi(rb.y)}, v = (f32x4){bflo(vb.x), bfhi(vb.x), bflo(vb.y), bfhi(vb.y)};
            const f32x4 gg = (f32x4){bflo(gb.x), bfhi(gb.x), bflo(gb.y), bfhi(gb.y)};
            const f32x4 a0 = (f32x4){bflo(a0b.x), bfhi(a0b.x), bflo(a0b.y), bfhi(a0b.y)}, a1 = (f32x4){bflo(a1b.x), bfhi(a1b.x), bflo(a1b.y), bfhi(a1b.y)};
            const f32x4 kb = k * ((a0 + a1 - 2.f) * ka + 2.f); const f32x4 pr = r * kb * rk;
            const float bs = red16(pr.x + pr.y + pr.z + pr.w);
            const f32x4 ov = (yn + v * bs) * gg; u32x2 w; w.x = pk2(ov.x, ov.y); w.y = pk2(ov.z, ov.w);
            *(u32x2*)(AO + o) = w;
        }
    }
    GRID_BAR();
    for (int rep_ = 0; rep_ < 1 + (int)((REPMASK >> 6) & 1u); ++rep_) { PH_VARS
        pg8::Gemm g{AO, WO, L, D, D, 0, 0}; pg8::StaticOrder S; S.init(L, D, G, bid);
        pg8::EpiRes E{IN(0), XL, MOD + 2 * 2048, nullptr};
        pg8::gemm_phase<pg8::EpiRes>(lds, g, S, E);
    }
    GRID_BAR();

#define NORM_ROWS(SRC, GAMMA, SC, SH, DST) do { const float* _srcb = (SRC); const float* _gm = (GAMMA); const float* _sc = (SC); const float* _sh = (SH); bf16_t* _dst = (DST); \
        for (int r = gw; r < L; r += 2 * NGW) { const int rb = r + NGW; const bool hb = rb < L; const float* srca = _srcb + (size_t)r * D; const float* srcb = _srcb + (size_t)(hb ? rb : r) * D; \
            f32x4 va[8], vb[8]; float sa = 0.f, sb = 0.f; \
            _Pragma("unroll") for (int j = 0; j < 8; ++j) { va[j] = *(const f32x4*)(srca + 4 * lane + 256 * j); vb[j] = *(const f32x4*)(srcb + 4 * lane + 256 * j); } \
            _Pragma("unroll") for (int j = 0; j < 8; ++j) { sa += va[j].x * va[j].x + va[j].y * va[j].y + va[j].z * va[j].z + va[j].w * va[j].w; sb += vb[j].x * vb[j].x + vb[j].y * vb[j].y + vb[j].z * vb[j].z + vb[j].w * vb[j].w; } \
            sa = wave_sum(sa); sb = wave_sum(sb); const float rsa = 1.0f / sqrtf(sa * (1.f / D) + 1e-6f), rsb = 1.0f / sqrtf(sb * (1.f / D) + 1e-6f); \
            _Pragma("unroll") for (int j = 0; j < 8; ++j) { const int c = 4 * lane + 256 * j; const f32x4 gv = *(const f32x4*)(_gm + c), sc = *(const f32x4*)(_sc + c), sh = *(const f32x4*)(_sh + c); \
                const f32x4 gs = gv * (sc + 1.f); const f32x4 oa = va[j] * rsa * gs + sh, ob = vb[j] * rsb * gs + sh; u32x2 wa, wb; wa.x = pk2(oa.x, oa.y); wa.y = pk2(oa.z, oa.w); wb.x = pk2(ob.x, ob.y); wb.y = pk2(ob.z, ob.w); \
                *(u32x2*)(_dst + (size_t)r * D + c) = wa; if (hb) *(u32x2*)(_dst + (size_t)rb * D + c) = wb; } } } while (0)

    for (int rep_ = 0; rep_ < 1 + (int)((REPMASK >> 7) & 1u); ++rep_) { PH_VARS
        NORM_ROWS(XL, IN(7), MOD + 4 * 2048, MOD + 3 * 2048, A2);
    }
    GRID_BAR();
    for (int rep_ = 0; rep_ < 1 + (int)((REPMASK >> 8) & 1u); ++rep_) { PH_VARS
        pg8::Gemm g{A2, WF13_0, L, 2 * FF, D, 0, 0}; pg8::StaticOrder S; S.init(L, 2 * FF, G, bid);
        pg8::EpiSwi E{HID};
        pg8::gemm_phase<pg8::EpiSwi>(lds, g, S, E);
        { const int ntile = (L / 256) * (2 * FF / 256), nbig = ntile - (ntile / G) * G;
          int Gf = G, cf = bid; bool act = true;
          if (nbig > 0 && nbig < G) { Gf = G - nbig; cf = bid - nbig; act = bid >= nbig; }
          if (act) { pg8::Gemm gf{WOUTP, HIDP, 4096, L, 256, 0, 0}; pg8::StaticOrder Sf; Sf.init(4096, L, Gf, cf);
              pg8::EpiFilt Ef{FILT};
              pg8::gemm_phase<pg8::EpiFilt>(lds, gf, Sf, Ef);
              { const float* cv = IN(1); const float* W1 = IN(4) + (size_t)D * 12288; const float* Bv1 = IN(5) + 12288;
                __syncthreads();
                for (int i = tid; i < D; i += NTHR) { const float v = cv[i]; smf[i] = v / (1.f + expf(-v)); }
                __syncthreads();
                LAS float* red = smf + D;
                for (int cb = cf; cb < 256; cb += Gf) {
                    const int col0 = cb * 48, c4 = tid % 12, rg = tid / 12;
                    if (rg < 42) { f32x4 aL1 = (f32x4){0.f, 0.f, 0.f, 0.f}; const float* w1p = W1 + col0 + 4 * c4;
#pragma unroll 7
                        for (int r = rg; r < D; r += 42) aL1 += *(const f32x4*)(w1p + (size_t)r * 12288) * smf[r];
#pragma unroll
                        for (int j = 0; j < 4; ++j) red[rg * 48 + 4 * c4 + j] = aL1[j]; }
                    __syncthreads();
                    if (tid < 48) { float s = 0.f;
                        for (int q = 0; q < 42; ++q) s += red[q * 48 + tid];
                        MOD[2 * 12288 + col0 + tid] = s + Bv1[col0 + tid]; }
                    __syncthreads();
                } } } }
    }
    GRID_BAR();
    for (int rep_ = 0; rep_ < 1 + (int)((REPMASK >> 9) & 1u); ++rep_) { PH_VARS
        pg8::Gemm g{HID, WF2_0, L, D, FF, 0, 0}; pg8::StaticOrder S; S.init(L, D, G, bid);
        pg8::EpiRes E{XL, XL, MOD + 5 * 2048, nullptr};
        pg8::gemm_phase<pg8::EpiRes>(lds, g, S, E);
    }
    GRID_BAR();

    for (int rep_ = 0; rep_ < 1 + (int)((REPMASK >> 10) & 1u); ++rep_) { PH_VARS NORM_ROWS(XL, IN(6) + D, MOD + 2 * 12288 + 2048, MOD + 2 * 12288, A2); }
    GRID_BAR();
    for (int rep_ = 0; rep_ < 1 + (int)((REPMASK >> 11) & 1u); ++rep_) { PH_VARS
        { pg8::Gemm g{A2, WHYIN, L, 3 * D, D, 0, 0}; pg8::StaticOrder S; S.init(L, 3 * D, G, bid);
          pg8::EpiBf16B E{UPRE, 3 * D, IN(30)};
          pg8::gemm_phase<pg8::EpiBf16B>(lds, g, S, E); }
    }
    GRID_BAR();
    for (int rep_ = 0; rep_ < 1 + (int)((REPMASK >> 12) & 1u); ++rep_) { PH_VARS
        const float* sw = IN(31); const float* sb = IN(32);
        LAS float* sx0 = smf; LAS float* svv = smf + 64 * 65;
        for (int tile = bid; tile < 128 * 32; tile += G) {
            const int tt = tile >> 5, ctile = tile & 31, t0 = tt * 64, cbase = ctile * 64;
            const int tl = tid >> 4, c4 = (tid & 15) * 4;
#pragma unroll
            for (int half = 0; half < 2; ++half) {
                const int t = t0 + half * 32 + tl; f32x4 u3[3];
#pragma unroll
                for (int gI = 0; gI < 3; ++gI) { const int col = gI * D + cbase + c4;
                    const f32x4 wA = *(const f32x4*)(sw + col), wB = *(const f32x4*)(sw + 3 * D + col), wC = *(const f32x4*)(sw + 6 * D + col), bb = *(const f32x4*)(sb + col);
#define LDU4(tt_) ({ const u32x2 _u = *(const u32x2*)(UPRE + (size_t)(tt_) * (3 * D) + col); (f32x4){bflo(_u.x), bfhi(_u.x), bflo(_u.y), bfhi(_u.y)}; })
                    f32x4 acc = bb + LDU4(t) * wB;
                    if (t > 0) acc += LDU4(t - 1) * wA;
                    if (t < L - 1) acc += LDU4(t + 1) * wC;
#undef LDU4
                    u3[gI] = acc; }
                const f32x4 vv = u3[2] * u3[1];
#pragma unroll
                for (int j = 0; j < 4; ++j) { sx0[(c4 + j) * 65 + half * 32 + tl] = u3[0][j]; svv[(c4 + j) * 65 + half * 32 + tl] = vv[j]; }
            }
            __syncthreads();
            { const int c = tid >> 3, t8 = (tid & 7) * 8; f32x4 o0, o1, p0, p1;
#pragma unroll
              for (int j = 0; j < 4; ++j) { o0[j] = sx0[c * 65 + t8 + j]; o1[j] = sx0[c * 65 + t8 + 4 + j]; p0[j] = svv[c * 65 + t8 + j]; p1[j] = svv[c * 65 + t8 + 4 + j]; }
              const size_t o = (size_t)(cbase + c) * L + t0 + t8;
              *(f32x4*)(X0T + o) = o0; *(f32x4*)(X0T + o + 4) = o1; *(f32x4*)(VVT + o) = p0; *(f32x4*)(VVT + o + 4) = p1; }
            __syncthreads();
        }
    }
    GRID_BAR();
    for (int rep_ = 0; rep_ < 1 + (int)((REPMASK >> 13) & 1u); ++rep_) { PH_VARS
        constexpr int M = 8192;
        LAS f32x2* Fz = (LAS f32x2*)lds_raw; LAS f32x2* Sz = Fz + M; LAS f32x2* TWL = Sz + M;
        const float* hbias = IN(41);
        for (int e = tid; e < 2048; e += NTHR) TWL[e] = TW1[e];
        __syncthreads();
#define CMUL(a, b) ((a) * (b).xx + (a).yx * (f32x2){-(b).y, (b).y})
#define CMULC(a, b) ((a) * (b).xx + (a).yx * (f32x2){(b).y, -(b).y})
        f32x2 nf[8], nb[8], ns[8];
#define FFT_PREFETCH(chn) do { const float* fwd_ = FILT + (size_t)(chn) * L; const float* bwd_ = FILT + (size_t)(D + (chn)) * L; const float* sig_ = VVT + (size_t)(chn) * L; const float* x0_ = X0T + (size_t)(chn) * L; \
            _Pragma("unroll") for (int u = 0; u < 8; ++u) { const int m = tid + 512 * u, idx = 8192 - 2 * m; \
                nf[u] = *(const f32x2*)(fwd_ + 2 * m); ns[u] = *(const f32x2*)(sig_ + 2 * m); (void)x0_; \
                nb[u].x = (idx == 8192) ? 0.f : bwd_[idx == 8192 ? 0 : idx]; nb[u].y = bwd_[idx - 1]; } } while (0)
        for (int ch = bid; ch < D; ch += G) {
            FFT_PREFETCH(ch);
#pragma unroll
            for (int u = 0; u < 8; ++u) { const int m = tid + 512 * u; Fz[m] = nf[u]; Fz[4096 + m] = nb[u]; Sz[m] = ns[u]; Sz[4096 + m] = (f32x2){0.f, 0.f}; }
            __syncthreads();
#pragma nounroll
            for (int R = 1; R <= 1024; R <<= 2) {
                f32x2 xf[4][4], xs[4][4];
#pragma unroll
                for (int u = 0; u < 4; ++u)
#pragma unroll
                    for (int q = 0; q < 4; ++q) { xf[u][q] = Fz[tid + 512 * u + 2048 * q]; xs[u][q] = Sz[tid + 512 * u + 2048 * q]; }
                __syncthreads();
#pragma unroll
                for (int u = 0; u < 4; ++u) { const int i = tid + 512 * u; const f32x2 w1 = TWL[i & ~(R - 1)]; const f32x2 w2 = CMUL(w1, w1); const f32x2 w3 = CMUL(w2, w1);
#define FWD_BF(XX, DST) do { const f32x2 t0 = XX[u][0] + XX[u][2], t1 = XX[u][0] - XX[u][2], t2 = XX[u][1] + XX[u][3], t3 = XX[u][1] - XX[u][3]; \
                        const f32x2 rot = t3.yx * (f32x2){1.f, -1.f}; const f32x2 y0 = t0 + t2, y2r = t0 - t2, y1r = t1 + rot, y3r = t1 - rot; \
                        const f32x2 y1 = CMUL(y1r, w1), y2 = CMUL(y2r, w2), y3 = CMUL(y3r, w3); \
                        *(LAS f32x4*)(DST + 4 * i) = (f32x4){y0.x, y0.y, y1.x, y1.y}; *(LAS f32x4*)(DST + 4 * i + 2) = (f32x4){y2.x, y2.y, y3.x, y3.y}; } while (0)
                    FWD_BF(xf, Fz); FWD_BF(xs, Sz);
#undef FWD_BF
                }
                __syncthreads();
            }
            {
                f32x2 xf[8][2], xs[8][2];
#pragma unroll
                for (int u = 0; u < 8; ++u) { xf[u][0] = Fz[tid + 512 * u]; xf[u][1] = Fz[tid + 512 * u + 4096]; xs[u][0] = Sz[tid + 512 * u]; xs[u][1] = Sz[tid + 512 * u + 4096]; }
                __syncthreads();
#pragma unroll
                for (int u = 0; u < 8; ++u) { const int i = tid + 512 * u; const f32x2 f0 = xf[u][0] + xf[u][1], f1 = xf[u][0] - xf[u][1], s0 = xs[u][0] + xs[u][1], s1 = xs[u][0] - xs[u][1];
                    *(LAS f32x4*)(Fz + 2 * i) = (f32x4){f0.x, f0.y, f1.x, f1.y}; *(LAS f32x4*)(Sz + 2 * i) = (f32x4){s0.x, s0.y, s1.x, s1.y}; }
                __syncthreads();
            }
            int tidS = tid; asm volatile("" : "+v"(tidS));
#pragma unroll 2
            for (int u = 0; u < 16; ++u) { const int pk = tidS + 512 * u;
                const int k = ((pk >> 11) & 3) | (((pk >> 9) & 3) << 2) | (((pk >> 7) & 3) << 4) | (((pk >> 5) & 3) << 6) | (((pk >> 3) & 3) << 8) | (((pk >> 1) & 3) << 10) | ((pk & 1) << 12);
                if (k > M / 2) continue;
                if (k == 0) { const f32x2 zs0 = Sz[0], zf0 = Fz[0];
                    const float Y0_ = (zs0.x + zs0.y) * (zf0.x + zf0.y), YM = (zs0.x - zs0.y) * (zf0.x - zf0.y);
                    Sz[0] = (f32x2){0.5f * (Y0_ + YM), 0.5f * (Y0_ - YM)}; }
                else {
                    const int kp = M - k;
                    int pkp = 0; { int kk2 = kp;
#pragma unroll
                        for (int st = 0; st < 6; ++st) { pkp = pkp * 4 + (kk2 & 3); kk2 >>= 2; }
                        pkp = pkp * 2 + kk2; }
                    f32x2 wk = (f32x2){0.f, -1.f};
                    if (k < M / 2) { const f32x2 wb = TWL[k >> 1]; const f32x2 c1 = (f32x2){0.9999999264657179f, -0.00038349518757139556f}; wk = (k & 1) ? CMUL(wb, c1) : wb; }
                    const f32x2 wkp = (f32x2){-wk.x, wk.y};
                    const f32x2 Sa = Sz[pk], Sb = Sz[pkp], Fa = Fz[pk], Fb = Fz[pkp];
#define XSPEC(Za, Zb, w, out) do { const f32x2 E_ = (f32x2){0.5f * (Za.x + Zb.x), 0.5f * (Za.y - Zb.y)}; const f32x2 Dd = (f32x2){0.5f * (Za.x - Zb.x), 0.5f * (Za.y + Zb.y)}; \
                        const f32x2 O_ = (f32x2){Dd.y, -Dd.x}; out = (f32x2){E_.x + w.x * O_.x - w.y * O_.y, E_.y + w.x * O_.y + w.y * O_.x}; } while (0)
                    f32x2 Xs_k, Xs_kp, Xf_k, Xf_kp;
                    XSPEC(Sa, Sb, wk, Xs_k); XSPEC(Sb, Sa, wkp, Xs_kp); XSPEC(Fa, Fb, wk, Xf_k); XSPEC(Fb, Fa, wkp, Xf_kp);
#undef XSPEC
                    const f32x2 Yk = CMUL(Xs_k, Xf_k), Ykp = CMUL(Xs_kp, Xf_kp);
                    { const f32x2 Ye = (f32x2){0.5f * (Yk.x + Ykp.x), 0.5f * (Yk.y - Ykp.y)}; const f32x2 Dd = (f32x2){0.5f * (Yk.x - Ykp.x), 0.5f * (Yk.y + Ykp.y)};
                      const f32x2 Yo = CMULC(Dd, wk);
                      Sz[pk] = (f32x2){Ye.x - Yo.y, Ye.y + Yo.x}; }
                    { const f32x2 Ye = (f32x2){0.5f * (Ykp.x + Yk.x), 0.5f * (Ykp.y - Yk.y)}; const f32x2 Dd = (f32x2){0.5f * (Ykp.x - Yk.x), 0.5f * (Ykp.y + Yk.y)};
                      const f32x2 Yo = CMULC(Dd, wkp);
                      Sz[pkp] = (f32x2){Ye.x - Yo.y, Ye.y + Yo.x}; }
                }
            }
            __syncthreads();
            {
                f32x4 xs[8];
#pragma unroll
                for (int u = 0; u < 8; ++u) xs[u] = *(const LAS f32x4*)(Sz + 2 * (tid + 512 * u));
                __syncthreads();
#pragma unroll
                for (int u = 0; u < 8; ++u) { const int i = tid + 512 * u; Sz[i] = (f32x2){xs[u].x + xs[u].z, xs[u].y + xs[u].w}; Sz[i + 4096] = (f32x2){xs[u].x - xs[u].z, xs[u].y - xs[u].w}; }
                __syncthreads();
            }
            f32x2 cs[8], cx[8];
            { const float* sig_ = VVT + (size_t)ch * L; const float* x0_ = X0T + (size_t)ch * L;
#pragma unroll
              for (int u = 0; u < 8; ++u) { cs[u] = *(const f32x2*)(sig_ + 2 * (tid + 512 * u)); cx[u] = *(const f32x2*)(x0_ + 2 * (tid + 512 * u)); } }
#pragma nounroll
            for (int R = 1024; R >= 1; R >>= 2) {
                f32x4 xa[4], xb[4];
#pragma unroll
                for (int u = 0; u < 4; ++u) { xa[u] = *(const LAS f32x4*)(Sz + 4 * (tid + 512 * u)); xb[u] = *(const LAS f32x4*)(Sz + 4 * (tid + 512 * u) + 2); }
                __syncthreads();
#pragma unroll
                for (int u = 0; u < 4; ++u) { const int i = tid + 512 * u; const f32x2 w1 = TWL[i & ~(R - 1)]; const f32x2 w2 = CMUL(w1, w1); const f32x2 w3 = CMUL(w2, w1);
                    const f32x2 a0 = (f32x2){xa[u].x, xa[u].y}, r1 = (f32x2){xa[u].z, xa[u].w}, r2 = (f32x2){xb[u].x, xb[u].y}, r3 = (f32x2){xb[u].z, xb[u].w};
                    const f32x2 a1 = CMULC(r1, w1), a2 = CMULC(r2, w2), a3 = CMULC(r3, w3);
                    const f32x2 t0 = a0 + a2, t1 = a0 - a2, t2 = a1 + a3, t3 = a1 - a3;
                    const f32x2 rot = t3.yx * (f32x2){1.f, -1.f}; Sz[i] = t0 + t2; Sz[i + 2048] = t1 - rot; Sz[i + 4096] = t0 - t2; Sz[i + 6144] = t1 + rot; }
                __syncthreads();
            }
            { const float hb = hbias[ch]; float* zp = ZT + (size_t)ch * L;
#pragma unroll
              for (int u = 0; u < 8; ++u) { const int m = tid + 512 * u; const f32x2 z = Sz[m];
                  f32x2 o; o.x = (z.x * (1.f / M) + cs[u].x * hb) * cx[u].x; o.y = (z.y * (1.f / M) + cs[u].y * hb) * cx[u].y; *(f32x2*)(zp + 2 * m) = o; } }
            __syncthreads();
        }
#undef FFT_PREFETCH
#undef CMUL
#undef CMULC
    }
    GRID_BAR();
    for (int rep_ = 0; rep_ < 1 + (int)((REPMASK >> 14) & 1u); ++rep_) { PH_VARS
        LAS float* st = smf;
        for (int tile = bid; tile < 32 * 32; tile += G) {
            const int tt = tile >> 5, ctile = tile & 31, t0 = tt * 256, cbase = ctile * 64;
            { const int c = tid >> 3, t8 = (tid & 7) * 8; f32x4 v0[4], v1[4];
#pragma unroll
              for (int q = 0; q < 4; ++q) { const size_t o = (size_t)(cbase + c) * L + t0 + 64 * q + t8; v0[q] = *(const f32x4*)(ZT + o); v1[q] = *(const f32x4*)(ZT + o + 4); }
#pragma unroll
              for (int q = 0; q < 4; ++q)
#pragma unroll
                for (int j = 0; j < 4; ++j) { st[c * 257 + 64 * q + t8 + j] = v0[q][j]; st[c * 257 + 64 * q + t8 + 4 + j] = v1[q][j]; } }
            __syncthreads();
#pragma unroll
            for (int q = 0; q < 4; ++q) { const int tl = 64 * q + (tid >> 3), c8 = (tid & 7) * 8; u32x4 w;
              w.x = pk2(st[(c8 + 0) * 257 + tl], st[(c8 + 1) * 257 + tl]); w.y = pk2(st[(c8 + 2) * 257 + tl], st[(c8 + 3) * 257 + tl]);
              w.z = pk2(st[(c8 + 4) * 257 + tl], st[(c8 + 5) * 257 + tl]); w.w = pk2(st[(c8 + 6) * 257 + tl], st[(c8 + 7) * 257 + tl]);
              *(u32x4*)(A2 + (size_t)(t0 + tl) * D + cbase + c8) = w; }
            __syncthreads();
        }
    }
    GRID_BAR();
    for (int rep_ = 0; rep_ < 1 + (int)((REPMASK >> 15) & 1u); ++rep_) { PH_VARS
        pg8::Gemm g{A2, WHYOUT, L, D, D, 0, 0}; pg8::StaticOrder S; S.init(L, D, G, bid);
        pg8::EpiRes E{XL, XL, MOD + 2 * 12288 + 2 * 2048, IN(43)};
        pg8::gemm_phase<pg8::EpiRes>(lds, g, S, E);
    }
    GRID_BAR();
    for (int rep_ = 0; rep_ < 1 + (int)((REPMASK >> 16) & 1u); ++rep_) { PH_VARS NORM_ROWS(XL, IN(7) + D, MOD + 2 * 12288 + 4 * 2048, MOD + 2 * 12288 + 3 * 2048, A2); }
    GRID_BAR();
    for (int rep_ = 0; rep_ < 1 + (int)((REPMASK >> 17) & 1u); ++rep_) { PH_VARS
        pg8::Gemm g{A2, WF13_1, L, 2 * FF, D, 0, 0}; pg8::StaticOrder S; S.init(L, 2 * FF, G, bid);
        pg8::EpiSwi E{HID};
        pg8::gemm_phase<pg8::EpiSwi>(lds, g, S, E);
    }
    GRID_BAR();
    for (int rep_ = 0; rep_ < 1 + (int)((REPMASK >> 18) & 1u); ++rep_) { PH_VARS
        pg8::Gemm g{HID, WF2_1, L, D, FF, 0, 0}; pg8::StaticOrder S; S.init(L, D, G, bid);
        pg8::EpiRes E{XL, XL, MOD + 2 * 12288 + 5 * 2048, nullptr};
        pg8::gemm_phase<pg8::EpiRes>(lds, g, S, E);
    }
    GRID_BAR();
    for (int rep_ = 0; rep_ < 1 + (int)((REPMASK >> 19) & 1u); ++rep_) { PH_VARS
        const float* fg = IN(44);
        for (int r = gw; r < L; r += NGW) { float* src = XL + (size_t)r * D; f32x4 v[8]; float s = 0.f;
#pragma unroll
            for (int j = 0; j < 8; ++j) { v[j] = *(const f32x4*)(src + 4 * lane + 256 * j); s += v[j].x * v[j].x + v[j].y * v[j].y + v[j].z * v[j].z + v[j].w * v[j].w; }
            s = wave_sum(s); const float rs = 1.0f / sqrtf(s * (1.f / D) + 1e-6f);
#pragma unroll
            for (int j = 0; j < 8; ++j) { const int c = 4 * lane + 256 * j; const f32x4 gv = *(const f32x4*)(fg + c); *(f32x4*)(src + c) = v[j] * rs * gv; } }
    }
}

extern "C" void kernel_launch(void* const* d_in, const int* in_sizes, int n_in, void* d_out, int out_size, void* d_ws, size_t ws_size, hipStream_t stream) {
    constexpr int LDS_BYTES = LDS_TOTAL;
    static int grid_blocks = 0;
    if (!grid_blocks) {
        int dev = 0, cus = 0, per_cu = 0;
        hipGetDevice(&dev);
        hipDeviceGetAttribute(&cus, hipDeviceAttributeMultiprocessorCount, dev);
        hipFuncSetAttribute((const void*)mega, hipFuncAttributeMaxDynamicSharedMemorySize, LDS_BYTES);
        hipOccupancyMaxActiveBlocksPerMultiprocessor(&per_cu, (const void*)mega, NTHR, LDS_BYTES);
        if (per_cu < 1) per_cu = 1;
        grid_blocks = cus * per_cu;
        if (grid_blocks > 256) grid_blocks = 256;
        if (ws_size < WS_NEED || n_in != 45) fprintf(stderr, "kernel_launch: ws %zu (need %zu), n_in %d\n", ws_size, (size_t)WS_NEED, n_in);
    }
    (void)hipMemsetAsync((char*)d_ws + WS_BAR, 0, XCD_BAR_WORDS * 4, stream);
    Args a{};
    for (int i = 0; i < 45; ++i) a.in[i] = (const float*)d_in[i];
    a.out = (float*)d_out; a.ws = (unsigned char*)d_ws;
    void* args[] = {&a};
    hipError_t e = hipLaunchCooperativeKernel((const void*)mega, dim3(grid_blocks), dim3(NTHR), args, LDS_BYTES, stream);
    if (e != hipSuccess) fprintf(stderr, "cooperative launch failed: %s (grid %d)\n", hipGetErrorString(e), grid_blocks);
}
```
